# Optimizing an MI355X kernel written in HIP

```python
import jax
import jax.numpy as jnp
from jax import lax
import numpy as np

D_MODEL = 1024
BATCH = 16
SEQ = 4096
DEPTH = 1

PLE_DIM = 256
HEAD_DIM = 64
NSA_WIDTH = D_MODEL // 2
RWKV_WIDTH = D_MODEL - NSA_WIDTH
NSA_HEADS = NSA_WIDTH // HEAD_DIM
NSA_KV_HEADS = 2
NSA_GROUP = NSA_HEADS // NSA_KV_HEADS
NSA_KV_WIDTH = NSA_KV_HEADS * HEAD_DIM
CMP_LEN = 32
CMP_STRIDE = 16
CMP_HIDDEN = 2 * HEAD_DIM
SEL_BLOCK = 64
SEL_TOPK = 16
WINDOW = 512
Q_BLOCK = 32
RWKV_HEADS = RWKV_WIDTH // HEAD_DIM
DECAY_LORA = 64
ICLR_LORA = 64
GATE_LORA = 128
D_FF = 4 * D_MODEL
NORM_EPS = 1e-6
GN_EPS = 64e-5
NEG_INF = -1e30
FORCE_SCORE = 1e4
NSA_SIZES = (NSA_WIDTH,) + (NSA_KV_WIDTH,) * 6 + (3 * NSA_HEADS,)
RWKV_SIZES = (RWKV_WIDTH,) * 3 + (DECAY_LORA, ICLR_LORA, GATE_LORA)
NSA_COLS = sum(NSA_SIZES)
RWKV_COLS = sum(RWKV_SIZES)
IN_COLS = NSA_COLS + RWKV_COLS

kernel_name = "hymba_nsa_rwkv7_sandwich_ple"


def rmsnorm(x, g):
    xf = x.astype(jnp.float32)
    y = xf * lax.rsqrt(jnp.mean(xf * xf, axis=-1, keepdims=True) + NORM_EPS)
    return (y * g.astype(jnp.float32)).astype(x.dtype)


def split_cols(z, sizes):
    return jnp.split(z, np.cumsum(sizes)[:-1].tolist(), axis=-1)


def alibi_slopes(n):
    return jnp.asarray([2.0 ** (-8.0 * (h + 1) / n) for h in range(n)], jnp.float32)


def masked_softmax(s, mask):
    p = jax.nn.softmax(jnp.where(mask, s.astype(jnp.float32), NEG_INF), axis=-1)
    return p * jnp.any(mask, axis=-1, keepdims=True)


def compress_blocks(kv, pe, w1, b1, w2):
    S = kv.shape[2]
    n_cmp = (S - CMP_LEN) // CMP_STRIDE + 1
    idx = jnp.arange(n_cmp)[:, None] * CMP_STRIDE + jnp.arange(CMP_LEN)[None, :]
    blocks = kv[:, :, idx] + pe
    flat = blocks.reshape(blocks.shape[:3] + (CMP_LEN * HEAD_DIM,))
    return jax.nn.gelu(flat @ w1 + b1) @ w2


def cmp_to_sel_map(n_cmp, n_sel):
    c0 = jnp.arange(n_cmp) * CMP_STRIDE
    s0 = jnp.arange(n_sel) * SEL_BLOCK
    ov = (jnp.minimum(c0[:, None] + CMP_LEN - 1, s0[None, :] + SEL_BLOCK - 1)
          - jnp.maximum(c0[:, None], s0[None, :]) + 1)
    return jnp.clip(ov, 0).astype(jnp.float32) / CMP_STRIDE


def nsa_mixer(q, k_cmp, v_cmp, k_slc, v_slc, k_win, v_win, gates, cmp_k_params, cmp_v_params):
    B, S, _ = q.shape
    G, R = NSA_KV_HEADS, NSA_GROUP
    f32 = jnp.float32
    qh = q.reshape(B, S, G, R, HEAD_DIM).transpose(0, 2, 3, 1, 4) * (HEAD_DIM ** -0.5)

    def kv_heads(t):
        return t.reshape(B, S, G, HEAD_DIM).transpose(0, 2, 1, 3)

    kc = compress_blocks(kv_heads(k_cmp), *cmp_k_params)
    vc = compress_blocks(kv_heads(v_cmp), *cmp_v_params)
    n_cmp = kc.shape[2]
    n_sel = S // SEL_BLOCK
    top_k = min(SEL_TOPK, n_sel)
    cmp_end = jnp.arange(n_cmp) * CMP_STRIDE + (CMP_LEN - 1)
    sel_map = cmp_to_sel_map(n_cmp, n_sel)
    ks_blk = kv_heads(k_slc).reshape(B, G, n_sel, SEL_BLOCK, HEAD_DIM)
    vs_blk = kv_heads(v_slc).reshape(B, G, n_sel, SEL_BLOCK, HEAD_DIM)
    pad = ((0, 0), (0, 0), (WINDOW, 0), (0, 0))
    kw_pad = jnp.pad(kv_heads(k_win), pad)
    vw_pad = jnp.pad(kv_heads(v_win), pad)
    gates = gates.reshape(B, S, G, R, 3).transpose(0, 2, 3, 1, 4)
    slopes = alibi_slopes(NSA_HEADS).reshape(G, R, 1, 1)
    b_idx = jnp.arange(B)[:, None, None, None]
    g_idx = jnp.arange(G)[None, :, None, None]
    sel_ids = jnp.arange(n_sel)

    def query_block(c0):
        t = c0 + jnp.arange(Q_BLOCK)
        qb = lax.dynamic_slice_in_dim(qh, c0, Q_BLOCK, axis=3)
        dist = (t[:, None] - cmp_end[None, :]).astype(f32)
        s = jnp.einsum('bgrqd,bgnd->bgrqn', qb, kc).astype(f32) - slopes * dist
        p_cmp = masked_softmax(s, dist >= 0)
        o_cmp = jnp.einsum('bgrqn,bgnd->bgrqd', p_cmp.astype(vc.dtype), vc)
        imp = jnp.einsum('bgrqn,nj->bgqj', p_cmp, sel_map)
        cur = (t // SEL_BLOCK)[:, None]
        forced = (sel_ids == 0) | (sel_ids == cur) | (sel_ids == cur - 1)
        score = jnp.where(forced, FORCE_SCORE, jnp.where(sel_ids <= cur, imp, -1.0))
        _, idx = lax.top_k(score, top_k)
        k_sel = ks_blk[b_idx, g_idx, idx]
        v_sel = vs_blk[b_idx, g_idx, idx]
        pos = idx[..., None] * SEL_BLOCK + jnp.arange(SEL_BLOCK)
        dist = (t[:, None, None] - pos)[:, :, None].astype(f32)
        s = jnp.einsum('bgrqd,bgqkld->bgrqkl', qb, k_sel).astype(f32) - slopes[..., None] * dist
        n_keys = top_k * SEL_BLOCK
        p_sel = masked_softmax(s.reshape(B, G, R, Q_BLOCK, n_keys),
                               (dist >= 0).reshape(B, G, 1, Q_BLOCK, n_keys))
        o_sel = jnp.einsum('bgrqkl,bgqkld->bgrqd', p_sel.reshape(s.shape).astype(v_sel.dtype), v_sel)
        kpos = c0 - WINDOW + jnp.arange(WINDOW + Q_BLOCK)
        kw = lax.dynamic_slice_in_dim(kw_pad, c0, WINDOW + Q_BLOCK, axis=2)
        vw = lax.dynamic_slice_in_dim(vw_pad, c0, WINDOW + Q_BLOCK, axis=2)
        dist = t[:, None] - kpos[None, :]
        mask = (kpos >= 0)[None, :] & (dist >= 0) & (dist < WINDOW)
        s = jnp.einsum('bgrqd,bgnd->bgrqn', qb, kw).astype(f32) - slopes * dist.astype(f32)
        p_win = masked_softmax(s, mask)
        o_win = jnp.einsum('bgrqn,bgnd->bgrqd', p_win.astype(vw.dtype), vw)
        gb = lax.dynamic_slice_in_dim(gates, c0, Q_BLOCK, axis=3)
        return gb[..., 0:1] * o_cmp + gb[..., 1:2] * o_sel + gb[..., 2:3] * o_win

    out = lax.map(query_block, jnp.arange(S // Q_BLOCK) * Q_BLOCK)
    return out.transpose(1, 0, 4, 2, 3, 5).reshape(B, S, NSA_WIDTH)


def wkv7_scan(r, w, k, v, a, b):
    B, S, H, N = r.shape
    xs = tuple(t.astype(jnp.float32).transpose(1, 0, 2, 3) for t in (r, w, k, v, a, b))

    def step(state, inp):
        r_t, w_t, k_t, v_t, a_t, b_t = inp
        sa = jnp.einsum('bhvk,bhk->bhv', state, a_t)
        state = (state * w_t[:, :, None, :] + sa[..., None] * b_t[:, :, None, :]
                 + v_t[..., None] * k_t[:, :, None, :])
        return state, jnp.einsum('bhvk,bhk->bhv', state, r_t)

    _, y = lax.scan(step, jnp.zeros((B, H, N, N), jnp.float32), xs)
    return y.transpose(1, 0, 2, 3)


def rwkv7_mixer(z, shift_mu, w0, w_lora_up, a0, a_lora_up, g_lora_up, k_k, k_a, r_k, lnx_w, lnx_b):
    B, S, _ = z.shape
    f32 = jnp.float32
    z_prev = jnp.pad(z, ((0, 0), (1, 0), (0, 0)))[:, :-1]
    z = z + (z_prev - z) * shift_mu
    r, k, v, wd, ad, gd = split_cols(z, RWKV_SIZES)
    w = -jax.nn.softplus(-(w0 + jnp.tanh(wd) @ w_lora_up)) - 0.5
    a = jax.nn.sigmoid(a0 + ad @ a_lora_up)
    g = jax.nn.sigmoid(gd) @ g_lora_up

    def hd(t):
        return t.reshape(B, S, RWKV_HEADS, HEAD_DIM)

    kk = hd(k * k_k).astype(f32)
    kk = kk * lax.rsqrt(jnp.maximum(jnp.sum(kk * kk, axis=-1, keepdims=True), 1e-24))
    k = k * (1.0 + (a - 1.0) * k_a)
    r, k, v, a = hd(r), hd(k), hd(v), hd(a)
    decay = jnp.exp(-jnp.exp(hd(w).astype(f32)))
    y = wkv7_scan(r, decay, k, v, -kk, kk * a)
    mu = jnp.mean(y, axis=-1, keepdims=True)
    var = jnp.mean(jnp.square(y - mu), axis=-1, keepdims=True)
    y = ((y - mu) * lax.rsqrt(var + GN_EPS) * lnx_w.reshape(RWKV_HEADS, HEAD_DIM)
         + lnx_b.reshape(RWKV_HEADS, HEAD_DIM))
    y = y + jnp.sum(r * k * r_k, axis=-1, keepdims=True) * v
    return (y.reshape(B, S, RWKV_WIDTH) * g).astype(z.dtype)


def hybrid_layer(x, p_l, g_mix_pre, g_mix_post, g_mlp_pre, g_mlp_post, w_in, nsa_gate_bias,
                 cmp_pe_k, cmp_k_w1, cmp_k_b1, cmp_k_w2, cmp_pe_v, cmp_v_w1, cmp_v_b1, cmp_v_w2,
                 shift_mu, w0, w_lora_up, a0, a_lora_up, g_lora_up, k_k, k_a, r_k, lnx_w, lnx_b,
                 w_out, w_up, w_down, w_ple, w_ple_gate):
    h = rmsnorm(x, g_mix_pre)
    z = h @ w_in
    q, kc, vc, ks, vs, kw, vw, gate_logits = split_cols(z[..., :NSA_COLS], NSA_SIZES)
    y_nsa = nsa_mixer(q, kc, vc, ks, vs, kw, vw, jax.nn.sigmoid(gate_logits + nsa_gate_bias),
                      (cmp_pe_k, cmp_k_w1, cmp_k_b1, cmp_k_w2), (cmp_pe_v, cmp_v_w1, cmp_v_b1, cmp_v_w2))
    y_rwkv = rwkv7_mixer(z[..., NSA_COLS:], shift_mu, w0, w_lora_up, a0, a_lora_up, g_lora_up,
                         k_k, k_a, r_k, lnx_w, lnx_b)
    mix = jnp.concatenate([y_nsa, y_rwkv], axis=-1) @ w_out
    x = x + rmsnorm(mix, g_mix_post)
    h = rmsnorm(x, g_mlp_pre)
    f = jnp.square(jax.nn.relu(h @ w_up)) @ w_down
    x = x + rmsnorm(f, g_mlp_post)
    return x + jax.nn.sigmoid(x @ w_ple_gate) * (p_l @ w_ple)


def setup_inputs(seed: int = 0) -> dict:
    key = jax.random.key(seed)
    keys = iter(jax.random.split(key, 40))
    L = DEPTH

    def nrm(shape, scale):
        return jax.random.normal(next(keys), shape, jnp.float32) * scale

    def gain(shape):
        return 1.0 + nrm(shape, 0.05)

    return {
        "x": nrm((BATCH, SEQ, D_MODEL), 1.0),
        "p": nrm((L, BATCH, SEQ, PLE_DIM), 1.0),
        "g_mix_pre": gain((L, D_MODEL)),
        "g_mix_post": gain((L, D_MODEL)),
        "g_mlp_pre": gain((L, D_MODEL)),
        "g_mlp_post": gain((L, D_MODEL)),
        "w_in": nrm((L, D_MODEL, IN_COLS), D_MODEL ** -0.5),
        "nsa_gate_bias": nrm((L, 3 * NSA_HEADS), 0.1),
        "cmp_pe_k": nrm((L, CMP_LEN, HEAD_DIM), 0.1),
        "cmp_k_w1": nrm((L, CMP_LEN * HEAD_DIM, CMP_HIDDEN), (CMP_LEN * HEAD_DIM) ** -0.5),
        "cmp_k_b1": nrm((L, CMP_HIDDEN), 0.02),
        "cmp_k_w2": nrm((L, CMP_HIDDEN, HEAD_DIM), CMP_HIDDEN ** -0.5),
        "cmp_pe_v": nrm((L, CMP_LEN, HEAD_DIM), 0.1),
        "cmp_v_w1": nrm((L, CMP_LEN * HEAD_DIM, CMP_HIDDEN), (CMP_LEN * HEAD_DIM) ** -0.5),
        "cmp_v_b1": nrm((L, CMP_HIDDEN), 0.02),
        "cmp_v_w2": nrm((L, CMP_HIDDEN, HEAD_DIM), CMP_HIDDEN ** -0.5),
        "shift_mu": jax.random.uniform(next(keys), (L, RWKV_COLS), jnp.float32),
        "w0": nrm((L, RWKV_WIDTH), 0.5),
        "w_lora_up": nrm((L, DECAY_LORA, RWKV_WIDTH), 0.5 * DECAY_LORA ** -0.5),
        "a0": nrm((L, RWKV_WIDTH), 0.5),
        "a_lora_up": nrm((L, ICLR_LORA, RWKV_WIDTH), ICLR_LORA ** -0.5),
        "g_lora_up": nrm((L, GATE_LORA, RWKV_WIDTH), GATE_LORA ** -0.5),
        "k_k": 0.85 + nrm((L, RWKV_WIDTH), 0.05),
        "k_a": gain((L, RWKV_WIDTH)),
        "r_k": nrm((L, RWKV_HEADS, HEAD_DIM), 0.1),
        "lnx_w": gain((L, RWKV_WIDTH)),
        "lnx_b": nrm((L, RWKV_WIDTH), 0.02),
        "w_out": nrm((L, D_MODEL, D_MODEL), D_MODEL ** -0.5),
        "w_up": nrm((L, D_MODEL, D_FF), D_MODEL ** -0.5),
        "w_down": nrm((L, D_FF, D_MODEL), D_FF ** -0.5),
        "w_ple": nrm((L, PLE_DIM, D_MODEL), PLE_DIM ** -0.5),
        "w_ple_gate": nrm((L, D_MODEL, D_MODEL), D_MODEL ** -0.5),
    }


def reference(x, p, g_mix_pre, g_mix_post, g_mlp_pre, g_mlp_post, w_in, nsa_gate_bias,
              cmp_pe_k, cmp_k_w1, cmp_k_b1, cmp_k_w2, cmp_pe_v, cmp_v_w1, cmp_v_b1, cmp_v_w2,
              shift_mu, w0, w_lora_up, a0, a_lora_up, g_lora_up, k_k, k_a, r_k, lnx_w, lnx_b,
              w_out, w_up, w_down, w_ple, w_ple_gate):
    for i in range(DEPTH):
        x = hybrid_layer(x, p[i], g_mix_pre[i], g_mix_post[i], g_mlp_pre[i], g_mlp_post[i], w_in[i],
                         nsa_gate_bias[i], cmp_pe_k[i], cmp_k_w1[i], cmp_k_b1[i], cmp_k_w2[i],
                         cmp_pe_v[i], cmp_v_w1[i], cmp_v_b1[i], cmp_v_w2[i], shift_mu[i], w0[i],
                         w_lora_up[i], a0[i], a_lora_up[i], g_lora_up[i], k_k[i], k_a[i], r_k[i],
                         lnx_w[i], lnx_b[i], w_out[i], w_up[i], w_down[i], w_ple[i], w_ple_gate[i])
    return x
```

```cpp
#include <hip/hip_runtime.h>
#include <hip/hip_cooperative_groups.h>
#include <cstdio>
#include <cstdint>
namespace cg = cooperative_groups;

#ifndef N_LAUNCH_MODE
#define N_LAUNCH_MODE 1
#endif

#define LAS __attribute__((address_space(3)))
typedef unsigned short bf16_t;
typedef short bf16x8 __attribute__((ext_vector_type(8)));
typedef short s16x4 __attribute__((ext_vector_type(4)));
typedef float f32x4 __attribute__((ext_vector_type(4)));
typedef float f32x2 __attribute__((ext_vector_type(2)));
typedef unsigned u32x4 __attribute__((ext_vector_type(4)));
typedef unsigned u32x2 __attribute__((ext_vector_type(2)));
typedef __bf16 bf16x2_t __attribute__((ext_vector_type(2)));

constexpr int NTOK = 65536, DM = 1024, SEQ = 4096, ZLD = 3328, DFF = 4096;
constexpr int ZQ = 0, ZKC = 512, ZVC = 640, ZKS = 768, ZKW = 896, ZVS = 1024, ZVW = 1152, ZR = 1280, ZK = 1792, ZV = 2304, ZWD = 2816, ZGT = 3072;
constexpr float NORM_EPS = 1e-6f, GN_EPS = 64e-5f;
constexpr int NPHASE = 12;
constexpr size_t MiB = (size_t)1 << 20;
constexpr size_t WS_WIN = 2 * MiB, WS_WOUT = 9 * MiB, WS_WUP = 11 * MiB, WS_WDN = 19 * MiB, WS_WPLE = 27 * MiB, WS_WPG = 28 * MiB;
constexpr size_t WS_ZERO = 30 * MiB, WS_ZERO_BYTES = 4 * MiB;
constexpr size_t WS_CK1 = 30 * MiB, WS_CV1 = 31 * MiB, WS_CK2 = 32 * MiB, WS_CV2 = 32 * MiB + 128 * 1024, WS_LORAT = 33 * MiB;
constexpr size_t WS_BIAS1 = 34 * MiB, WS_RS1 = 35 * MiB, WS_RS2 = 35 * MiB + 512 * 1024, WS_PSQ = 36 * MiB;
constexpr size_t WS_CHK = 40 * MiB, WS_CHV = 44 * MiB, WS_KC = 48 * MiB, WS_VCT = 52 * MiB, WS_VST = 54 * MiB, WS_VWT = 70 * MiB;
constexpr size_t WS_PB = 86 * MiB, WS_LORAA = 118 * MiB, WS_RB = 150 * MiB, WS_RC = 278 * MiB, WS_RA = 406 * MiB, WS_END = 918 * MiB;
constexpr int LDS_BYTES = 155648;

struct Args { const float* in[32]; float* out; unsigned char* ws; int ph_lo, ph_hi; };

__device__ __forceinline__ unsigned pk2(float lo, float hi) { f32x2 v = {lo, hi}; bf16x2_t b = __builtin_convertvector(v, bf16x2_t); return __builtin_bit_cast(unsigned, b); }
__device__ __forceinline__ bf16_t f2bf(float x) { return (bf16_t)(pk2(x, 0.f) & 0xffffu); }
__device__ __forceinline__ float bf_lo(unsigned w) { return __uint_as_float(w << 16); }
__device__ __forceinline__ float bf_hi(unsigned w) { return __uint_as_float(w & 0xffff0000u); }
__device__ __forceinline__ float bf2f(bf16_t h) { return __uint_as_float((unsigned)h << 16); }
__device__ __forceinline__ float sigm(float x) { return __builtin_amdgcn_rcpf(1.f + __expf(-x)); }
__device__ __forceinline__ void unpack8(const u32x4 w, float (&f)[8]) {
    f[0] = bf_lo(w.x); f[1] = bf_hi(w.x); f[2] = bf_lo(w.y); f[3] = bf_hi(w.y); f[4] = bf_lo(w.z); f[5] = bf_hi(w.z); f[6] = bf_lo(w.w); f[7] = bf_hi(w.w); }
__device__ __forceinline__ u32x4 pack8(const float (&f)[8]) { u32x4 w; w.x = pk2(f[0], f[1]); w.y = pk2(f[2], f[3]); w.z = pk2(f[4], f[5]); w.w = pk2(f[6], f[7]); return w; }
__device__ __forceinline__ float wave_sum(float v) {
#pragma unroll
    for (int o = 1; o < 64; o <<= 1) v += __shfl_xor(v, o);
    return v; }
#define LDS_WAIT() asm volatile("s_waitcnt lgkmcnt(0)" ::: "memory")

namespace pg8 {
constexpr int BM = 256, BK = 64, HALF = 128, HTB = HALF * BK * 2, STAGE_BYTES = 8 * HTB, NXCD = 8, WGM = 8;
__host__ __device__ __forceinline__ int lds_byte(int r, int c) { const int st = (r >> 4) * 2 + (c >> 5), rr = r & 15, cc = c & 31, ob = rr * 64 + cc * 2; return st * 1024 + (ob ^ (((ob >> 9) & 1) << 5)); }
__host__ __device__ __forceinline__ void stage_rc(int b, int& R, int& C) { const int st = b / 1024, sb = b % 1024, swz = sb ^ (((sb >> 9) & 1) << 5); R = (st >> 1) * 16 + swz / 64; C = (st & 1) * 32 + (swz % 64) / 2; }
__host__ __device__ __forceinline__ int perm32(int rho) { const int n = rho >> 4, i = rho & 15; return 8 * (i >> 2) + 4 * n + (i & 3); }

struct Unit { int pm, pn; };
struct Gemm { const bf16_t* A; const bf16_t* Bt; int M, N, K; long lda; long akstep; int amode; };
__device__ __forceinline__ size_t a_unit_off(const Gemm& g, int pm) {
    if (g.amode == 1) return ((size_t)(pm >> 1) * SEQ * ZLD + (size_t)(pm & 1) * 64) * 2;
    return (size_t)pm * BM * (size_t)g.lda * 2; }

struct StaticOrder {
    int nM, nN, nwg, G, c;
    __host__ __device__ void init(int M, int N, int G_, int c_) { nM = M / BM; nN = N / BM; nwg = nM * nN; G = G_; c = c_; }
    __host__ __device__ bool next(int i, Unit& u) const {
        const long L = (long)i * G + c; if (L >= nwg) return false;
        int wgid = (int)L; { const int q = nwg / NXCD, r = nwg % NXCD, xcd = wgid % NXCD, off = wgid / NXCD; wgid = (xcd < r ? xcd * (q + 1) : r * (q + 1) + (xcd - r) * q) + off; }
        const int nig = WGM * nN, gid = wgid / nig, fm = gid * WGM, gsz = (nM - fm) < WGM ? (nM - fm) : WGM;
        u.pm = fm + ((wgid % nig) % gsz); u.pn = (wgid % nig) / gsz; return true;
    }
};

template <class Epi, class Sched, bool ALIGN_EPI = true, bool SP2 = true>
__device__ __forceinline__ void gemm_phase(LAS unsigned char* lds, const Gemm g, const Sched& S, const Epi& E) {
    const int tid = threadIdx.x, wid = __builtin_amdgcn_readfirstlane(tid >> 6), lane = tid & 63, wr = wid >> 2, wc = wid & 3, fr = lane & 15, fq = lane >> 4;
    const int K = g.K, nt = K / BK;
    unsigned voffA[2], voffB[2];
#pragma unroll
    for (int i = 0; i < 2; ++i) { int R, C; stage_rc(tid * 16 + i * 8192, R, C); const int Rb = Epi::PERM ? ((R & ~31) + perm32(R & 31)) : R;
        voffA[i] = (unsigned)((long)R * g.lda + C) * 2u; voffB[i] = (unsigned)(Rb * K + C) * 2u; }
    const size_t kstepA = (size_t)g.akstep, kstepB = (size_t)(BK * 2);
    const size_t hstepA = (size_t)HALF * (size_t)g.lda * 2, hstepB = (size_t)HALF * K * 2;
    const size_t tstepB = 2 * hstepB;
    const unsigned ldsw = (unsigned)wid * 1024u;
    const int aoff = lds_byte(wr * 64 + fr, fq * 8), boff = lds_byte(wc * 32 + fr, fq * 8);
#define PG8_SA(b, h) (((b) * 2 + (h)) * HTB)
#define PG8_SB(b, h) ((4 + (b) * 2 + (h)) * HTB)
#define PG8_STAGE(bufoff, gbase, voff) do { _Pragma("unroll") for (int _i = 0; _i < 2; ++_i) \
        __builtin_amdgcn_global_load_lds((const unsigned*)((const char*)(gbase) + (voff)[_i]), (LAS unsigned*)(lds + (bufoff) + ldsw + _i * 8192), 16, 0, 0); } while (0)
#define PG8_LDA(dst, b, h) do { _Pragma("unroll") for (int m = 0; m < 4; ++m) _Pragma("unroll") for (int k = 0; k < 2; ++k) dst[m][k] = *(const LAS bf16x8*)(lds + PG8_SA(b, h) + aoff + m * 2048 + k * 1024); } while (0)
#define PG8_LDB(dst, b, h) do { _Pragma("unroll") for (int n = 0; n < 2; ++n) _Pragma("unroll") for (int k = 0; k < 2; ++k) dst[n][k] = *(const LAS bf16x8*)(lds + PG8_SB(b, h) + boff + n * 2048 + k * 1024); } while (0)
#define PG8_MMA(ai, bj, At, Bt) do { __builtin_amdgcn_s_setprio(1); _Pragma("unroll") for (int m = 0; m < 4; ++m) _Pragma("unroll") for (int n = 0; n < 2; ++n) _Pragma("unroll") for (int k = 0; k < 2; ++k) \
        acc[ai][bj][m][n] = __builtin_amdgcn_mfma_f32_16x16x32_bf16(Bt[n][k], At[m][k], acc[ai][bj][m][n], 0, 0, 0); __builtin_amdgcn_s_setprio(0); } while (0)
#define PG8_WAIT_V(n) asm volatile("s_waitcnt vmcnt(" #n ")" ::: "memory")
#define PG8_WAIT_L(n) asm volatile("s_waitcnt lgkmcnt(" #n ")" ::: "memory")
#define PG8_BAR __builtin_amdgcn_s_barrier()
#define PG8_SCHED __builtin_amdgcn_sched_barrier(0)
    Unit cur, nxt; int ui = 0;
    if (!S.next(0, cur)) return;
    f32x4 acc[2][2][4][2];
#pragma unroll
    for (int a = 0; a < 2; ++a)
#pragma unroll
        for (int b = 0; b < 2; ++b)
#pragma unroll
            for (int m = 0; m < 4; ++m)
#pragma unroll
                for (int n = 0; n < 2; ++n) acc[a][b][m][n] = (f32x4){0.f, 0.f, 0.f, 0.f};
    bf16x8 At[4][2], B0[2][2], B1[2][2];
    const char* cA = (const char*)g.A + a_unit_off(g, cur.pm); const char* cB = (const char*)g.Bt + (size_t)cur.pn * tstepB;
    if constexpr (SP2) {
        PG8_STAGE(PG8_SB(0, 0), cB, voffB); PG8_STAGE(PG8_SB(0, 1), cB + hstepB, voffB); PG8_STAGE(PG8_SA(0, 0), cA, voffA); PG8_STAGE(PG8_SA(0, 1), cA + hstepA, voffA);
        if (wr == 1) PG8_BAR;
        PG8_WAIT_V(2); PG8_BAR;
        PG8_STAGE(PG8_SB(1, 0), cB + kstepB, voffB); PG8_STAGE(PG8_SA(1, 0), cA + kstepA, voffA); PG8_STAGE(PG8_SB(1, 1), cB + hstepB + kstepB, voffB);
        PG8_WAIT_V(6); PG8_BAR;
    } else {
        PG8_STAGE(PG8_SB(0, 0), cB, voffB); PG8_STAGE(PG8_SA(0, 0), cA, voffA); PG8_STAGE(PG8_SB(0, 1), cB + hstepB, voffB); PG8_STAGE(PG8_SA(0, 1), cA + hstepA, voffA);
        if (wr == 1) PG8_BAR;
        PG8_WAIT_V(4); PG8_BAR;
        PG8_STAGE(PG8_SB(1, 0), cB + kstepB, voffB); PG8_STAGE(PG8_SA(1, 0), cA + kstepA, voffA); PG8_STAGE(PG8_SB(1, 1), cB + hstepB + kstepB, voffB);
        PG8_WAIT_V(6); PG8_BAR;
    }
    for (;;) {
        const bool has_next = S.next(ui + 1, nxt);
        const char* nA = has_next ? (const char*)g.A + a_unit_off(g, nxt.pm) : cA; const char* nB = has_next ? (const char*)g.Bt + (size_t)nxt.pn * tstepB : cB;
#pragma nounroll
        for (int t = 0; t < nt; t += 2) {
            const bool last = (t == nt - 2);
            const char* a1 = cA + (size_t)(t + 1) * kstepA;
            const char* a2 = last ? nA : cA + (size_t)(t + 2) * kstepA; const char* b2 = last ? nB : cB + (size_t)(t + 2) * kstepB;
            const char* a3 = a2 + kstepA; const char* b3 = b2 + kstepB;
            if constexpr (SP2) {
            PG8_LDB(B0, 0, 0); PG8_LDB(B1, 0, 1); PG8_SCHED; PG8_LDA(At, 0, 0); PG8_STAGE(PG8_SA(1, 1), a1 + hstepA, voffA);
            PG8_WAIT_V(8); PG8_WAIT_L(0); PG8_BAR; PG8_MMA(0, 0, At, B0); PG8_MMA(0, 1, At, B1); PG8_BAR; PG8_SCHED;
            PG8_LDA(At, 0, 1); PG8_STAGE(PG8_SB(0, 0), b2, voffB); PG8_STAGE(PG8_SB(0, 1), b2 + hstepB, voffB); PG8_STAGE(PG8_SA(0, 0), a2, voffA);
            PG8_WAIT_V(8); PG8_WAIT_L(0); PG8_BAR; PG8_MMA(1, 0, At, B0); PG8_MMA(1, 1, At, B1); PG8_BAR; PG8_SCHED;
            PG8_LDB(B0, 1, 0); PG8_LDB(B1, 1, 1); PG8_SCHED; PG8_LDA(At, 1, 0); PG8_STAGE(PG8_SA(0, 1), a2 + hstepA, voffA);
            PG8_WAIT_V(8); PG8_WAIT_L(0); PG8_BAR; PG8_MMA(0, 0, At, B0); PG8_MMA(0, 1, At, B1); PG8_BAR; PG8_SCHED;
            PG8_LDA(At, 1, 1); PG8_STAGE(PG8_SB(1, 0), b3, voffB); PG8_STAGE(PG8_SB(1, 1), b3 + hstepB, voffB); PG8_STAGE(PG8_SA(1, 0), a3, voffA);
            PG8_WAIT_V(8); PG8_WAIT_L(0); PG8_BAR; PG8_MMA(1, 0, At, B0); PG8_MMA(1, 1, At, B1); PG8_BAR; PG8_SCHED;
            } else {
            PG8_LDB(B0, 0, 0); PG8_SCHED; PG8_LDA(At, 0, 0); PG8_STAGE(PG8_SA(1, 1), a1 + hstepA, voffA);
            PG8_WAIT_L(8); PG8_BAR; PG8_WAIT_L(0); PG8_MMA(0, 0, At, B0); PG8_BAR; PG8_SCHED;
            PG8_LDB(B1, 0, 1); PG8_STAGE(PG8_SB(0, 0), b2, voffB);
            PG8_BAR; PG8_WAIT_L(0); PG8_MMA(0, 1, At, B1); PG8_BAR;
            PG8_LDA(At, 0, 1); PG8_STAGE(PG8_SA(0, 0), a2, voffA);
            PG8_BAR; PG8_WAIT_L(0); PG8_MMA(1, 0, At, B0); PG8_BAR; PG8_SCHED;
            PG8_STAGE(PG8_SB(0, 1), b2 + hstepB, voffB);
            PG8_WAIT_V(6); PG8_BAR; PG8_MMA(1, 1, At, B1); PG8_BAR;
            PG8_LDB(B0, 1, 0); PG8_SCHED; PG8_LDA(At, 1, 0); PG8_STAGE(PG8_SA(0, 1), a2 + hstepA, voffA);
            PG8_WAIT_L(8); PG8_BAR; PG8_WAIT_L(0); PG8_MMA(0, 0, At, B0); PG8_BAR; PG8_SCHED;
            PG8_LDB(B1, 1, 1); PG8_STAGE(PG8_SB(1, 0), b3, voffB);
            PG8_BAR; PG8_WAIT_L(0); PG8_MMA(0, 1, At, B1); PG8_BAR;
            PG8_LDA(At, 1, 1); PG8_STAGE(PG8_SA(1, 0), a3, voffA);
            PG8_BAR; PG8_WAIT_L(0); PG8_MMA(1, 0, At, B0); PG8_BAR; PG8_SCHED;
            PG8_STAGE(PG8_SB(1, 1), b3 + hstepB, voffB);
            PG8_WAIT_V(6); PG8_BAR; PG8_MMA(1, 1, At, B1); PG8_BAR;
            }
        }
        if constexpr (ALIGN_EPI) { if (wr == 0) PG8_BAR; }
        E(acc, cur, wr, wc, fr, fq);
        if (!has_next) break;
#pragma unroll
        for (int a = 0; a < 2; ++a)
#pragma unroll
            for (int b = 0; b < 2; ++b)
#pragma unroll
                for (int m = 0; m < 4; ++m)
#pragma unroll
                    for (int n = 0; n < 2; ++n) acc[a][b][m][n] = (f32x4){0.f, 0.f, 0.f, 0.f};
        cur = nxt; cA = nA; cB = nB; ++ui;
        if constexpr (ALIGN_EPI) { if (wr == 1) PG8_BAR; }
    }
    PG8_WAIT_V(0);
    if constexpr (!ALIGN_EPI) { if (wr == 0) PG8_BAR; }
    PG8_BAR;
#undef PG8_SA
#undef PG8_SB
#undef PG8_STAGE
#undef PG8_LDA
#undef PG8_LDB
#undef PG8_MMA
#undef PG8_WAIT_V
#undef PG8_WAIT_L
#undef PG8_BAR
#undef PG8_SCHED
}
}

template <int MODE> struct Epi {
    static constexpr bool PERM = true;
    bf16_t* O; int ldc; const float* rowscale; const float* bias; float* psq; bf16_t* OT; float* outf; const bf16_t* pe;
    __device__ __forceinline__ void operator()(const f32x4 (&acc)[2][2][4][2], const pg8::Unit& u, int wr, int wc, int fr, int fq) const {
#pragma unroll
        for (int ai = 0; ai < 2; ++ai)
#pragma unroll
            for (int m = 0; m < 4; ++m) {
                const int r = u.pm * 256 + ai * 128 + wr * 64 + m * 16 + fr;
                float rs = 1.f;
                if (MODE == 0 || MODE == 5) rs = rowscale[r];
                float ssq = 0.f;
#pragma unroll
                for (int bj = 0; bj < 2; ++bj) {
                    const int c0 = u.pn * 256 + bj * 128 + wc * 32 + 8 * fq;
                    const f32x4 a0 = acc[ai][bj][m][0], a1 = acc[ai][bj][m][1];
                    float v[8] = {a0[0], a0[1], a0[2], a0[3], a1[0], a1[1], a1[2], a1[3]};
                    if (MODE == 0) {
#pragma unroll
                        for (int j = 0; j < 8; ++j) v[j] *= rs;
                        if (u.pn == 4) {
                            const int b = r >> 12, t = r & 4095, cc = wc * 32 + 8 * fq;
                            bf16_t* vt = OT + (size_t)bj * ((size_t)16 * 128 * 4096) + ((size_t)(b * 128 + cc)) * 4096 + t;
#pragma unroll
                            for (int j = 0; j < 8; ++j) vt[(size_t)j * 4096] = f2bf(v[j]);
                        } else {
                            *(u32x4*)(O + (size_t)r * ldc + c0) = pack8(v);
                        }
                    } else if (MODE == 1) {
                        const f32x4 b0 = *(const f32x4*)(bias + c0), b1 = *(const f32x4*)(bias + c0 + 4);
                        const float bb[8] = {b0[0], b0[1], b0[2], b0[3], b1[0], b1[1], b1[2], b1[3]};
#pragma unroll
                        for (int j = 0; j < 8; ++j) { const float x = v[j] + bb[j]; const float uu = 0.7978845608028654f * (x + 0.044715f * x * x * x); v[j] = x * sigm(2.f * uu); }
                        *(u32x4*)(O + (size_t)r * ldc + c0) = pack8(v);
                    } else if (MODE == 2) {
                        *(u32x4*)(O + (size_t)r * ldc + c0) = pack8(v);
                    } else if (MODE == 3) {
                        if (u.pn == 0 && c0 < 64) {
                            const int bg = r >> 8, n = r & 255;
#pragma unroll
                            for (int j = 0; j < 8; ++j) OT[((size_t)(bg * 64 + c0 + j)) * 256 + n] = f2bf(v[j]);
                        }
                    } else if (MODE == 4) {
#pragma unroll
                        for (int j = 0; j < 8; ++j) ssq += v[j] * v[j];
                        *(u32x4*)(O + (size_t)r * ldc + c0) = pack8(v);
                    } else if (MODE == 5) {
#pragma unroll
                        for (int j = 0; j < 8; ++j) { const float x = fmaxf(v[j] * rs, 0.f); v[j] = x * x; }
                        *(u32x4*)(O + (size_t)r * ldc + c0) = pack8(v);
                    } else if (MODE == 6) {
                        float* op = outf + (size_t)r * DM + c0;
                        const u32x4 xw = *(const u32x4*)(O + (size_t)r * DM + c0);
                        float xf[8]; unpack8(xw, xf);
                        const u32x4 pw = *(const u32x4*)(pe + (size_t)r * DM + c0);
                        float pf[8]; unpack8(pw, pf);
                        f32x4 o0, o1;
#pragma unroll
                        for (int j = 0; j < 4; ++j) { o0[j] = xf[j] + sigm(v[j]) * pf[j]; o1[j] = xf[4 + j] + sigm(v[4 + j]) * pf[4 + j]; }
                        *(f32x4*)op = o0; *(f32x4*)(op + 4) = o1;
                    }
                }
                if (MODE == 4) {
                    ssq += __shfl_xor(ssq, 16); ssq += __shfl_xor(ssq, 32);
                    if (fq == 0) psq[(size_t)r * 16 + u.pn * 4 + wc] = ssq;
                }
                asm volatile("" ::: "memory");
            }
    }
};

template <int MODE>
__device__ __forceinline__ void run_gemm(LAS unsigned char* lds, const bf16_t* A, const bf16_t* Bt, int M, int N, int K, long lda, long akstep, int amode, int c, const Epi<MODE>& E) {
    pg8::Gemm g{A, Bt, M, N, K, lda, akstep, amode};
    pg8::StaticOrder S; S.init(M, N, (int)gridDim.x, c);
    pg8::gemm_phase<Epi<MODE>, pg8::StaticOrder, true, true>(lds, g, S, E);
}

__device__ __forceinline__ void tr_matrix(const float* W, int K, int ldn, int c0src, int ncols, bf16_t* WT, int ldk, int dst_row0, int dst_k0,
                                          const float* rsc, float cs, LAS float* scr, int gw, int NGW, int lane) {
    const int nkb = K / 64, nnb = (ncols + 31) / 32, nit = nkb * nnb;
    for (int it = gw; it < nit; it += NGW) {
        const int kb = it / nnb, nb = it % nnb, k0 = kb * 64, n0 = nb * 32, ncv = (ncols - n0) < 32 ? (ncols - n0) : 32;
#pragma unroll 8
        for (int i = 0; i < 32; ++i) { const int kk = 2 * i + (lane >> 5), col = lane & 31;
            float val = 0.f;
            if (col < ncv) { val = W[(size_t)(k0 + kk) * ldn + c0src + n0 + col]; if (rsc) val *= rsc[k0 + kk]; val *= cs; }
            scr[kk * 33 + col] = val; }
        LDS_WAIT(); asm volatile("" ::: "memory");
        const int c = lane & 7;
#pragma unroll
        for (int j = 0; j < 4; ++j) { const int n = (lane >> 3) + 8 * j; const LAS float* s = scr + (8 * c) * 33 + n;
            if (n < ncv) {
                u32x4 o; o.x = pk2(s[0 * 33], s[1 * 33]); o.y = pk2(s[2 * 33], s[3 * 33]); o.z = pk2(s[4 * 33], s[5 * 33]); o.w = pk2(s[6 * 33], s[7 * 33]);
                *(u32x4*)(WT + (size_t)(dst_row0 + n0 + n) * ldk + dst_k0 + k0 + 8 * c) = o; } }
        LDS_WAIT(); asm volatile("" ::: "memory");
    }
}

template <int CTRL> __device__ __forceinline__ float dppf(float x) { return __int_as_float(__builtin_amdgcn_update_dpp(0, __float_as_int(x), CTRL, 0xF, 0xF, false)); }
__device__ __forceinline__ float allred16(float x) { x += dppf<0xB1>(x); x += dppf<0x4E>(x); x += dppf<0x141>(x); x += dppf<0x140>(x); return x; }

#define MFMA16K16(a, b, c) __builtin_amdgcn_mfma_f32_16x16x16bf16_1k(a, b, c, 0, 0, 0)
#define MFMA16x32(a, b, c) __builtin_amdgcn_mfma_f32_16x16x32_bf16(a, b, c, 0, 0, 0)
constexpr int S2_CHB = 12544, S2_APT = 0, S2_RT = 2304, S2_WT = 4608, S2_BRT = 5120, S2_KRT = 5632, S2_B2T = 6144, S2_K2T = 8192, S2_VT = 10240, S2_GC = 12288;
constexpr int S2_PS = 2 * 4 * S2_CHB, S2_PSB = 8960, S2_AT = 0, S2_BT = 2304, S2_KT = 4608, S2_ATT = 6912;
constexpr int S2_N = 0, S2_NT = 512, S2_N2 = 1024, S2_N2T = 1536, S2_N4 = 2048, S2_N4T = 2560, S2_N8T = 3072, S2_P = 3584, S2_AAK = 4096, S2_TT = 4608;
constexpr int S2_CS = S2_PS + 4 * S2_PSB, S2_CSB = 2816, S2_SB = 0, S2_SG = 2304;
static_assert(S2_CS + 4 * S2_CSB <= LDS_BYTES, "scan LDS map");

__device__ __forceinline__ f32x4 mm64(const LAS unsigned char* A, const LAS unsigned char* B, f32x4 c, int l15, int g4) {
    const bf16x8 a0 = *(const LAS bf16x8*)(A + l15 * 144 + g4 * 16), a1 = *(const LAS bf16x8*)(A + l15 * 144 + g4 * 16 + 64);
    const bf16x8 b0 = *(const LAS bf16x8*)(B + l15 * 144 + g4 * 16), b1 = *(const LAS bf16x8*)(B + l15 * 144 + g4 * 16 + 64);
    c = MFMA16x32(a0, b0, c); c = MFMA16x32(a1, b1, c); return c; }
__device__ __forceinline__ f32x4 mm16(const LAS unsigned char* A, const LAS unsigned char* B, f32x4 c, int l15, int g4) {
    const s16x4 a = *(const LAS s16x4*)(A + l15 * 32 + g4 * 8), b = *(const LAS s16x4*)(B + l15 * 32 + g4 * 8);
    return MFMA16K16(a, b, c); }
__device__ __forceinline__ void st_T(LAS unsigned char* base, int row_bytes, f32x4 d, int l15, int g4) {
    u32x2 w; w.x = pk2(d[0], d[1]); w.y = pk2(d[2], d[3]); *(LAS u32x2*)(base + l15 * row_bytes + g4 * 8) = w; }
__device__ __forceinline__ void st_RM(LAS unsigned char* base, f32x4 d, int l15, int g4) {
#pragma unroll
    for (int i = 0; i < 4; ++i) *(LAS bf16_t*)(base + (4 * g4 + i) * 32 + l15 * 2) = f2bf(d[i]); }
__device__ __forceinline__ float wsum64(float x) {
    x = allred16(x);
    const float t0 = __int_as_float(__builtin_amdgcn_readlane(__float_as_int(x), 0)), t1 = __int_as_float(__builtin_amdgcn_readlane(__float_as_int(x), 16));
    const float t2 = __int_as_float(__builtin_amdgcn_readlane(__float_as_int(x), 32)), t3 = __int_as_float(__builtin_amdgcn_readlane(__float_as_int(x), 48));
    return (t0 + t1) + (t2 + t3); }

__device__ __forceinline__ void s2_load(const bf16_t* z, const bf16_t* lo, int b, int hc, int tok0, unsigned (&rw)[16][5], unsigned (&pv3)[3]) {
    const size_t row0 = (size_t)b * SEQ + tok0;
    pv3[0] = 0u; pv3[1] = 0u; pv3[2] = 0u;
    if (tok0 > 0) { const bf16_t* zp = z + (row0 - 1) * ZLD; pv3[0] = zp[ZR + hc]; pv3[1] = zp[ZK + hc]; pv3[2] = zp[ZV + hc]; }
#pragma unroll
    for (int t = 0; t < 16; ++t) {
        const bf16_t* zr = z + (row0 + t) * ZLD;
        rw[t][0] = zr[ZR + hc]; rw[t][1] = zr[ZK + hc]; rw[t][2] = zr[ZV + hc];
        rw[t][3] = lo[(row0 + t) * 1536 + hc]; rw[t][4] = lo[(row0 + t) * 1536 + 512 + hc];
    }
}
__device__ __forceinline__ void s2_produce(LAS unsigned char* CB, LAS unsigned char* PSb, LAS unsigned char* APTp, const unsigned (&rw)[16][5], const unsigned (&pv3)[3], int lane,
        float mur, float muk, float muv, float w0v, float a0v, float kkv, float kav) {
    const int l15 = lane & 15, g4 = lane >> 4;
    asm volatile("" ::: "memory");
    float pr = __uint_as_float(pv3[0] << 16), pk = __uint_as_float(pv3[1] << 16), pv = __uint_as_float(pv3[2] << 16);
    float btv[16], ktv[16]; unsigned atp[8], vtp[8];
    float Lam = 0.f, eP = 1.f, hold_a = 0.f, hold_v = 0.f;
#pragma unroll
    for (int t = 0; t < 16; ++t) {
        const float cr = __uint_as_float(rw[t][0] << 16), ck = __uint_as_float(rw[t][1] << 16), cv = __uint_as_float(rw[t][2] << 16);
        const float lw = __uint_as_float(rw[t][3] << 16), la = __uint_as_float(rw[t][4] << 16);
        const float r = cr + (pr - cr) * mur, k = ck + (pk - ck) * muk, v = cv + (pv - cv) * muv;
        pr = cr; pk = ck; pv = cv;
        const float aic = sigm(a0v + la);
        const float lam = -0.6065306597126334f * __builtin_amdgcn_rcpf(1.f + __expf(-(w0v + lw)));
        const float kk = k * kkv; const float ss = wsum64(kk * kk);
        const float kn = kk * rsqrtf(fmaxf(ss, 1e-24f));
        const float k2 = k * (1.f + (aic - 1.f) * kav);
        Lam += lam;
        const float eL = __expf(Lam), eLm = __builtin_amdgcn_rcpf(eL);
        const float at = -kn * eP, rt = r * eL, bt = kn * aic * eLm, kt = k2 * eLm;
        eP = eL;
        *(LAS bf16_t*)(PSb + S2_AT + t * 144 + lane * 2) = f2bf(at);
        *(LAS bf16_t*)(PSb + S2_BT + t * 144 + lane * 2) = f2bf(bt);
        *(LAS bf16_t*)(PSb + S2_KT + t * 144 + lane * 2) = f2bf(kt);
        *(LAS bf16_t*)(CB + S2_RT + t * 144 + lane * 2) = f2bf(rt);
        btv[t] = bt; ktv[t] = kt;
        if (t & 1) { atp[t >> 1] = pk2(hold_a, at); vtp[t >> 1] = pk2(hold_v, v); } else { hold_a = at; hold_v = v; }
    }
    const float gC = eP;
    *(LAS float*)(CB + S2_GC + lane * 4) = gC;
    { u32x4 w0 = {atp[0], atp[1], atp[2], atp[3]}, w1 = {atp[4], atp[5], atp[6], atp[7]};
      *(LAS u32x4*)(PSb + S2_ATT + lane * 32) = w0; *(LAS u32x4*)(PSb + S2_ATT + lane * 32 + 16) = w1;
      u32x4 v0 = {vtp[0], vtp[1], vtp[2], vtp[3]}, v1 = {vtp[4], vtp[5], vtp[6], vtp[7]};
      *(LAS u32x4*)(CB + S2_VT + lane * 32) = v0; *(LAS u32x4*)(CB + S2_VT + lane * 32 + 16) = v1;
      u32x4 b0, b1, k0, k1;
      b0.x = pk2(btv[0] * gC, btv[1] * gC); b0.y = pk2(btv[2] * gC, btv[3] * gC); b0.z = pk2(btv[4] * gC, btv[5] * gC); b0.w = pk2(btv[6] * gC, btv[7] * gC);
      b1.x = pk2(btv[8] * gC, btv[9] * gC); b1.y = pk2(btv[10] * gC, btv[11] * gC); b1.z = pk2(btv[12] * gC, btv[13] * gC); b1.w = pk2(btv[14] * gC, btv[15] * gC);
      k0.x = pk2(ktv[0] * gC, ktv[1] * gC); k0.y = pk2(ktv[2] * gC, ktv[3] * gC); k0.z = pk2(ktv[4] * gC, ktv[5] * gC); k0.w = pk2(ktv[6] * gC, ktv[7] * gC);
      k1.x = pk2(ktv[8] * gC, ktv[9] * gC); k1.y = pk2(ktv[10] * gC, ktv[11] * gC); k1.z = pk2(ktv[12] * gC, ktv[13] * gC); k1.w = pk2(ktv[14] * gC, ktv[15] * gC);
      *(LAS u32x4*)(CB + S2_B2T + lane * 32) = b0; *(LAS u32x4*)(CB + S2_B2T + lane * 32 + 16) = b1;
      *(LAS u32x4*)(CB + S2_K2T + lane * 32) = k0; *(LAS u32x4*)(CB + S2_K2T + lane * 32 + 16) = k1; }
    asm volatile("" ::: "memory");
    const f32x4 z4 = {0.f, 0.f, 0.f, 0.f};
    f32x4 dN = mm64(PSb + S2_BT, PSb + S2_AT, z4, l15, g4);
    f32x4 dAak = mm64(PSb + S2_KT, PSb + S2_AT, z4, l15, g4);
    f32x4 dBr = mm64(PSb + S2_BT, CB + S2_RT, z4, l15, g4);
    f32x4 dKr = mm64(PSb + S2_KT, CB + S2_RT, z4, l15, g4);
    f32x4 P;
#pragma unroll
    for (int i = 0; i < 4; ++i) { const int sidx = 4 * g4 + i;
        dN[i] = (sidx < l15) ? dN[i] : 0.f; dAak[i] = (sidx < l15) ? dAak[i] : 0.f;
        dBr[i] = (sidx <= l15) ? dBr[i] : 0.f; dKr[i] = (sidx <= l15) ? dKr[i] : 0.f;
        P[i] = dN[i] + ((sidx == l15) ? 1.f : 0.f); }
    asm volatile("s_waitcnt lgkmcnt(0)" ::: "memory");
    st_RM(PSb + S2_N, dN, l15, g4); st_T(PSb + S2_NT, 32, dN, l15, g4); st_RM(PSb + S2_AAK, dAak, l15, g4);
    st_T(CB + S2_BRT, 32, dBr, l15, g4); st_T(CB + S2_KRT, 32, dKr, l15, g4);
    st_RM(PSb + S2_P, P, l15, g4);
    asm volatile("" ::: "memory");
    const f32x4 n2 = mm16(PSb + S2_N, PSb + S2_NT, z4, l15, g4);
    asm volatile("" ::: "memory");
    st_RM(PSb + S2_N2, n2, l15, g4); st_T(PSb + S2_N2T, 32, n2, l15, g4);
    asm volatile("" ::: "memory");
    P = mm16(PSb + S2_P, PSb + S2_N2T, P, l15, g4);
    asm volatile("s_waitcnt lgkmcnt(0)" ::: "memory");
    st_RM(PSb + S2_P, P, l15, g4);
    asm volatile("" ::: "memory");
    const f32x4 n4 = mm16(PSb + S2_N2, PSb + S2_N2T, z4, l15, g4);
    asm volatile("" ::: "memory");
    st_RM(PSb + S2_N4, n4, l15, g4); st_T(PSb + S2_N4T, 32, n4, l15, g4);
    asm volatile("" ::: "memory");
    P = mm16(PSb + S2_P, PSb + S2_N4T, P, l15, g4);
    asm volatile("s_waitcnt lgkmcnt(0)" ::: "memory");
    st_RM(PSb + S2_P, P, l15, g4);
    asm volatile("" ::: "memory");
    const f32x4 n8 = mm16(PSb + S2_N4, PSb + S2_N4T, z4, l15, g4);
    asm volatile("" ::: "memory");
    st_T(PSb + S2_N8T, 32, n8, l15, g4);
    asm volatile("" ::: "memory");
    const f32x4 Tm = mm16(PSb + S2_P, PSb + S2_N8T, P, l15, g4);
    asm volatile("" ::: "memory");
    st_T(PSb + S2_TT, 32, Tm, l15, g4);
    asm volatile("" ::: "memory");
    const f32x4 W = mm16(PSb + S2_AAK, PSb + S2_TT, z4, l15, g4);
    asm volatile("" ::: "memory");
    st_T(CB + S2_WT, 32, W, l15, g4);
#pragma unroll
    for (int kt = 0; kt < 4; ++kt) {
        const f32x4 ap = mm16(PSb + S2_ATT + kt * 512, PSb + S2_TT, z4, l15, g4);
        st_T(APTp + kt * 32, 144, ap, l15, g4);
    }
}

__device__ __forceinline__ unsigned char* s2_block(unsigned char* ws, float* out, int c) {
    if (c < 10699) return ws + WS_RC + (size_t)c * S2_CHB;
    c -= 10699; if (c < 8024) return ws + WS_RA + (size_t)416 * MiB + (size_t)c * S2_CHB;
    c -= 8024; if (c < 5349) return (unsigned char*)out + (size_t)192 * MiB + (size_t)c * S2_CHB;
    c -= 5349; if (c < 2674) return ws + WS_LORAA + (size_t)c * S2_CHB;
    c -= 2674; return ws + WS_END + (size_t)c * S2_CHB;
}
__device__ __forceinline__ void scan_precompute(LAS unsigned char* lds, const Args& a, const bf16_t* z, const bf16_t* lo) {
    const int tid = threadIdx.x, lane = tid & 63, wid = __builtin_amdgcn_readfirstlane(tid >> 6);
    LAS unsigned char* WB = lds + wid * (S2_CHB - 2304 + S2_PSB);
    LAS unsigned char* CB = WB - 2304; LAS unsigned char* PSb = WB + (S2_CHB - 2304);
    const int nw = (int)gridDim.x * 8;
    unsigned rwA[16][5], pvA[3];
    { const int c = (int)blockIdx.x * 8 + wid; if (c < 32768) s2_load(z, lo, c >> 11, ((c >> 8) & 7) * 64 + lane, (c & 255) * 16, rwA, pvA); }
    const bool fixed_h = (nw & 2047) == 0;
    int hc = ((((int)blockIdx.x * 8 + wid) >> 8) & 7) * 64 + lane;
    float mur = a.in[16][hc], muk = a.in[16][512 + hc], muv = a.in[16][1024 + hc], w0v = a.in[17][hc], a0v = a.in[19][hc], kkv = a.in[22][hc], kav = a.in[23][hc];
    for (int c = (int)blockIdx.x * 8 + wid; c < 32768; c += nw) {
        if (!fixed_h) { hc = ((c >> 8) & 7) * 64 + lane;
            mur = a.in[16][hc]; muk = a.in[16][512 + hc]; muv = a.in[16][1024 + hc]; w0v = a.in[17][hc]; a0v = a.in[19][hc]; kkv = a.in[22][hc]; kav = a.in[23][hc]; }
        unsigned rwB[16][5], pvB[3];
        { const int cn = c + nw; if (cn < 32768) s2_load(z, lo, cn >> 11, ((cn >> 8) & 7) * 64 + lane, (cn & 255) * 16, rwB, pvB); }
        s2_produce(CB, PSb, PSb, rwA, pvA, lane, mur, muk, muv, w0v, a0v, kkv, kav);
#pragma unroll
        for (int t = 0; t < 16; ++t)
#pragma unroll
            for (int q = 0; q < 5; ++q) rwA[t][q] = rwB[t][q];
        pvA[0] = pvB[0]; pvA[1] = pvB[1]; pvA[2] = pvB[2];
        asm volatile("s_waitcnt lgkmcnt(0)" ::: "memory");
        u32x4* dst = (u32x4*)s2_block(a.ws, a.out, c);
#pragma unroll
        for (int k = 0; k < 3; ++k) { const int idx = lane + 64 * k; if (idx < 144) __builtin_nontemporal_store(*(const LAS u32x4*)(PSb + idx * 16), dst + idx); }
#pragma unroll
        for (int k = 0; k < 10; ++k) { const int idx = lane + 64 * k; __builtin_nontemporal_store(*(const LAS u32x4*)(WB + idx * 16), dst + 144 + idx); }
        asm volatile("s_waitcnt lgkmcnt(0)" ::: "memory");
    }
}
__device__ __forceinline__ void scan_phase(LAS unsigned char* lds, const Args& a, const bf16_t* z, const bf16_t* lo, float* yraw) {
    const int tid = threadIdx.x, lane = tid & 63, wid = __builtin_amdgcn_readfirstlane(tid >> 6);
    const int l15 = lane & 15, g4 = lane >> 4;
    constexpr int NIT = SEQ / 64;
    for (int unit = blockIdx.x; unit < 128; unit += gridDim.x) {
        const int b = unit >> 3, h = unit & 7;
        __syncthreads();
        if (wid >= 4) {
            const int pw = wid - 4, c0 = unit * 256;
            { const u32x4* src = (const u32x4*)s2_block(a.ws, a.out, c0 + pw); LAS unsigned char* dstl = lds + (0 * 4 + pw) * S2_CHB;
              u32x4 tmp[13];
#pragma unroll
              for (int k = 0; k < 13; ++k) { const int idx = lane + 64 * k; if (idx < S2_CHB / 16) tmp[k] = __builtin_nontemporal_load(src + idx); }
#pragma unroll
              for (int k = 0; k < 13; ++k) { const int idx = lane + 64 * k; if (idx < S2_CHB / 16) *(LAS u32x4*)(dstl + idx * 16) = tmp[k]; } }
            __syncthreads();
            for (int it = 0; it < NIT; ++it) {
                if (it + 1 < NIT) { const u32x4* src = (const u32x4*)s2_block(a.ws, a.out, c0 + (it + 1) * 4 + pw); LAS unsigned char* dstl = lds + (((it + 1) & 1) * 4 + pw) * S2_CHB;
                  u32x4 tmp[13];
#pragma unroll
                  for (int k = 0; k < 13; ++k) { const int idx = lane + 64 * k; if (idx < S2_CHB / 16) tmp[k] = __builtin_nontemporal_load(src + idx); }
#pragma unroll
                  for (int k = 0; k < 13; ++k) { const int idx = lane + 64 * k; if (idx < S2_CHB / 16) *(LAS u32x4*)(dstl + idx * 16) = tmp[k]; } }
                __syncthreads();
            }
        } else {
            const int vt = wid;
            LAS unsigned char* SB = lds + S2_CS + vt * S2_CSB + S2_SB; LAS unsigned char* SG = lds + S2_CS + vt * S2_CSB + S2_SG;
            f32x4 St[4];
#pragma unroll
            for (int kt = 0; kt < 4; ++kt) St[kt] = (f32x4){0.f, 0.f, 0.f, 0.f};
            __syncthreads();
            for (int it = 0; it < NIT; ++it) {
                for (int j = 0; j < 4; ++j) {
                    const LAS unsigned char* CB = lds + ((it & 1) * 4 + j) * S2_CHB;
                    asm volatile("" ::: "memory");
                    s16x4 sbf[4];
#pragma unroll
                    for (int kt = 0; kt < 4; ++kt) { u32x2 w; w.x = pk2(St[kt][0], St[kt][1]); w.y = pk2(St[kt][2], St[kt][3]); sbf[kt] = __builtin_bit_cast(s16x4, w); }
                    const s16x4 vtf = *(const LAS s16x4*)(CB + S2_VT + (vt * 16 + l15) * 32 + g4 * 8);
                    f32x4 sg = {0.f, 0.f, 0.f, 0.f};
                    { const s16x4 wf = *(const LAS s16x4*)(CB + S2_WT + l15 * 32 + g4 * 8);
                      sg = MFMA16K16(wf, vtf, sg);
#pragma unroll
                      for (int kt = 0; kt < 4; ++kt) { const s16x4 af = *(const LAS s16x4*)(CB + S2_APT + l15 * 144 + kt * 32 + g4 * 8); sg = MFMA16K16(af, sbf[kt], sg); } }
                    s16x4 sgf; { u32x2 w; w.x = pk2(sg[0], sg[1]); w.y = pk2(sg[2], sg[3]); sgf = __builtin_bit_cast(s16x4, w); }
                    f32x4 yy = {0.f, 0.f, 0.f, 0.f};
                    { const s16x4 brf = *(const LAS s16x4*)(CB + S2_BRT + l15 * 32 + g4 * 8), krf = *(const LAS s16x4*)(CB + S2_KRT + l15 * 32 + g4 * 8);
                      yy = MFMA16K16(krf, vtf, yy);
#pragma unroll
                      for (int kt = 0; kt < 4; ++kt) { const s16x4 rf = *(const LAS s16x4*)(CB + S2_RT + l15 * 144 + kt * 32 + g4 * 8); yy = MFMA16K16(rf, sbf[kt], yy); }
                      yy = MFMA16K16(brf, sgf, yy); }
                    { bf16_t* yp = (bf16_t*)yraw + ((size_t)b * SEQ + it * 64 + j * 16 + 4 * g4) * 512 + h * 64 + vt * 16 + l15;
#pragma unroll
                      for (int i = 0; i < 4; ++i) yp[(size_t)i * 512] = f2bf(yy[i]); }
#pragma unroll
                    for (int kt = 0; kt < 4; ++kt) {
                        const f32x4 gc = *(const LAS f32x4*)(CB + S2_GC + (16 * kt + 4 * g4) * 4);
                        const s16x4 b2f = *(const LAS s16x4*)(CB + S2_B2T + (16 * kt + l15) * 32 + g4 * 8), k2f = *(const LAS s16x4*)(CB + S2_K2T + (16 * kt + l15) * 32 + g4 * 8);
                        f32x4 sn = St[kt] * gc;
                        sn = MFMA16K16(k2f, vtf, sn); sn = MFMA16K16(b2f, sgf, sn);
                        St[kt] = sn;
                    }
                }
                __syncthreads();
            }
        }
    }
}

constexpr int NS_KCL = 0, NS_VCL = 36864, NS_IMP = 70656, NS_SELM = 137216, NS_UNI = 137728;
constexpr int NS_KT = NS_IMP, NS_VT = NS_IMP + 9216;

#define MFMA16(a, b, c) __builtin_amdgcn_mfma_f32_16x16x32_bf16(a, b, c, 0, 0, 0)

template <int MODE>
__device__ __forceinline__ void flash_tile(const LAS unsigned char* lds, unsigned kt_off, unsigned vt_off, const bf16x8 (&Qf)[2][2], f32x4 (&O)[4][2],
        float (&mrun)[2], float (&lrun)[2], float slope, const int (&tq)[2], int key0, const bool (&selb)[2], int l15, int g4, bool full) {
    asm volatile("" : "+v"(kt_off), "+v"(vt_off));
    const LAS unsigned char* KT = lds + kt_off; const LAS unsigned char* VT = lds + vt_off;
    f32x4 sc[4][2];
    float cb[2];
#pragma unroll
    for (int qs = 0; qs < 2; ++qs) cb[qs] = slope * (float)(key0 + 4 * g4 - tq[qs]) + ((MODE == 1 && !selb[qs]) ? -1e30f : 0.f);
    __builtin_amdgcn_s_setprio(1);
#pragma unroll
    for (int s = 0; s < 4; ++s) {
        const LAS unsigned char* kp = KT + (s * 16) * 144;
        const bf16x8 k0 = *(const LAS bf16x8*)kp, k1 = *(const LAS bf16x8*)(kp + 64);
#pragma unroll
        for (int qs = 0; qs < 2; ++qs) {
            f32x4 zz;
#pragma unroll
            for (int i = 0; i < 4; ++i) zz[i] = fmaf(slope, (float)(s * 16 + i), cb[qs]);
            zz = MFMA16(k0, Qf[qs][0], zz);
            sc[s][qs] = MFMA16(k1, Qf[qs][1], zz);
        }
        __builtin_amdgcn_sched_barrier(0);
    }
    __builtin_amdgcn_s_setprio(0);
    if (!full) {
#pragma unroll
        for (int qs = 0; qs < 2; ++qs)
#pragma unroll
            for (int s = 0; s < 4; ++s)
#pragma unroll
                for (int i = 0; i < 4; ++i) {
                    const int dist = (tq[qs] - key0 - 4 * g4) - (s * 16 + i);
                    const bool ok = (MODE == 1) ? (dist >= 0) : (dist >= 0 && dist < 512);
                    sc[s][qs][i] = ok ? sc[s][qs][i] : -1e30f;
                }
    }
#pragma unroll
    for (int qs = 0; qs < 2; ++qs) {
        float mx = -1e30f;
#pragma unroll
        for (int s = 0; s < 4; ++s)
#pragma unroll
            for (int i = 0; i < 4; ++i) mx = fmaxf(mx, sc[s][qs][i]);
        mx = fmaxf(mx, __shfl_xor(mx, 16)); mx = fmaxf(mx, __shfl_xor(mx, 32));
        const float mn = fmaxf(mrun[qs], mx);
        const float alpha = __builtin_amdgcn_exp2f(mrun[qs] - mn);
        mrun[qs] = mn;
        const float mnx = fmaxf(mn, -1e29f);
        float ps = 0.f;
#pragma unroll
        for (int s = 0; s < 4; ++s)
#pragma unroll
            for (int i = 0; i < 4; ++i) { const float p = __builtin_amdgcn_exp2f(sc[s][qs][i] - mnx); sc[s][qs][i] = p; ps += p; }
        lrun[qs] = lrun[qs] * alpha + ps;
#pragma unroll
        for (int d = 0; d < 4; ++d) O[d][qs] = O[d][qs] * alpha;
    }
    __builtin_amdgcn_s_setprio(1);
#pragma unroll
    for (int kk = 0; kk < 2; ++kk) {
        bf16x8 Pf[2];
#pragma unroll
        for (int qs = 0; qs < 2; ++qs) { u32x4 w; w.x = pk2(sc[2 * kk][qs][0], sc[2 * kk][qs][1]); w.y = pk2(sc[2 * kk][qs][2], sc[2 * kk][qs][3]);
            w.z = pk2(sc[2 * kk + 1][qs][0], sc[2 * kk + 1][qs][1]); w.w = pk2(sc[2 * kk + 1][qs][2], sc[2 * kk + 1][qs][3]); Pf[qs] = __builtin_bit_cast(bf16x8, w); }
#pragma unroll
        for (int d = 0; d < 4; ++d) {
            const LAS unsigned char* vp = VT + (d * 16) * 144 + (kk * 32) * 2;
            const s16x4 lo = *(const LAS s16x4*)vp, hi = *(const LAS s16x4*)(vp + 32);
            const bf16x8 Vf = {lo[0], lo[1], lo[2], lo[3], hi[0], hi[1], hi[2], hi[3]};
#pragma unroll
            for (int qs = 0; qs < 2; ++qs) O[d][qs] = MFMA16(Vf, Pf[qs], O[d][qs]);
            __builtin_amdgcn_sched_barrier(0);
        }
    }
    __builtin_amdgcn_s_setprio(0);
}

__device__ __forceinline__ void nsa_fetch(u32x4& kv, u32x4& vv, const bf16_t* kbase, size_t kstride, const bf16_t* vtbase, size_t vstride, int tid) {
    const int row = tid >> 3, ch = tid & 7;
    kv = *(const u32x4*)(kbase + (size_t)row * kstride + ch * 8);
    vv = *(const u32x4*)(vtbase + (size_t)row * vstride + ch * 8);
}
__device__ __forceinline__ void nsa_commit(LAS unsigned char* lds, const u32x4 kv, const u32x4 vv, int tid) {
    const int row = tid >> 3, ch = tid & 7;
    *(LAS u32x4*)(lds + NS_KT + row * 144 + ch * 16) = kv;
    *(LAS u32x4*)(lds + NS_VT + row * 144 + ch * 16) = vv;
}

__device__ __forceinline__ void nsa_phase(LAS unsigned char* lds, const Args& a, const bf16_t* z, const bf16_t* KC, const bf16_t* VCT, const bf16_t* VST, const bf16_t* VWT, bf16_t* A2, int ldo, bool merged) {
    const int tid = threadIdx.x, lane = tid & 63, wid = __builtin_amdgcn_readfirstlane(tid >> 6);
    const int l15_ = lane & 15, g4_ = lane >> 4, hr = wid >> 1, qh = wid & 1;
    LAS float* IMP = (LAS float*)(lds + NS_IMP);
    LAS unsigned* SELM = (LAS unsigned*)(lds + NS_SELM);
    LAS unsigned* UNI = (LAS unsigned*)(lds + NS_UNI);
    const float* gbias = a.in[7];
#ifndef NSA_REP
#define NSA_REP 1
#endif
    const bool kc_resident = (gridDim.x & 31) == 0;
    if (kc_resident) {
        const int bg0 = (int)blockIdx.x & 31;
        __syncthreads();
#pragma unroll
        for (int it = 0; it < 4; ++it) {
            const int row = it * 64 + (tid >> 3), ch = tid & 7;
            *(LAS u32x4*)(lds + NS_KCL + row * 144 + ch * 16) = *(const u32x4*)(KC + ((size_t)bg0 * 256 + row) * 256 + ch * 8);
            const int dim = tid >> 3, c16 = (tid & 7) + 8 * it;
            *(LAS u32x4*)(lds + NS_VCL + dim * 528 + c16 * 16) = *(const u32x4*)(VCT + ((size_t)bg0 * 64 + dim) * 256 + c16 * 8);
        }
    }
    const int nun = merged ? (((int)blockIdx.x < 128) ? 7 : 9) : (2048 * NSA_REP - (int)blockIdx.x + (int)gridDim.x - 1) / (int)gridDim.x;
    for (int ui = 0; ui < nun; ++ui) {
        const int uu = merged ? ((ui < 8) ? (int)blockIdx.x + 256 * ui : (int)blockIdx.x - 128 + 1792) : (int)blockIdx.x + ui * (int)gridDim.x;
        const int unit = uu & 2047;
        const int bg = unit & 31, qt = ((unit >> 8) & 1) ? ((unit >> 5) ^ 7) : (unit >> 5), b = bg >> 1, g = bg & 1, t0 = qt * 64, cur = qt;
        const int hq = g * 4 + hr;
        const float slope = exp2f(-(float)(hq + 1)) * 1.4426950408889634f;
        const size_t row0 = (size_t)b * SEQ + t0;
        int l15 = l15_, g4 = g4_; asm volatile("" : "+v"(l15), "+v"(g4));
        int tidv = tid; asm volatile("" : "+v"(tidv));
        unsigned kt_off = NS_KT + l15 * 144 + g4 * 16, vt_off = NS_VT + l15 * 144 + g4 * 8;
        unsigned kcl_off = NS_KCL + l15 * 144 + g4 * 16, vcl_off = NS_VCL + l15 * 528 + g4 * 8;
        asm volatile("" : "+v"(kcl_off), "+v"(vcl_off));
        __syncthreads();
        if (!kc_resident) {
#pragma unroll
            for (int it = 0; it < 4; ++it) {
                const int row = it * 64 + (tid >> 3), ch = tid & 7;
                *(LAS u32x4*)(lds + NS_KCL + row * 144 + ch * 16) = *(const u32x4*)(KC + ((size_t)bg * 256 + row) * 256 + ch * 8);
                const int dim = tid >> 3, c16 = (tid & 7) + 8 * it;
                *(LAS u32x4*)(lds + NS_VCL + dim * 528 + c16 * 16) = *(const u32x4*)(VCT + ((size_t)bg * 64 + dim) * 256 + c16 * 8);
            }
        }
        if (tid == 0) { UNI[0] = 0u; UNI[1] = 0u; }
        bf16x8 Qf[2][2]; int tq[2]; float gate[2][3];
#pragma unroll
        for (int qs = 0; qs < 2; ++qs) {
            const int ql = qh * 32 + qs * 16 + l15; tq[qs] = t0 + ql;
            const bf16_t* zr = z + (row0 + ql) * ZLD;
            Qf[qs][0] = *(const bf16x8*)(zr + ZQ + hq * 64 + g4 * 8);
            Qf[qs][1] = *(const bf16x8*)(zr + ZQ + hq * 64 + 32 + g4 * 8);
#pragma unroll
            for (int br = 0; br < 3; ++br) gate[qs][br] = sigm(bf2f(zr[ZGT + hq * 3 + br]) + gbias[hq * 3 + br]);
        }
        f32x4 Y[4][2];
#pragma unroll
        for (int d = 0; d < 4; ++d) { Y[d][0] = (f32x4){0.f, 0.f, 0.f, 0.f}; Y[d][1] = Y[d][0]; }
        __syncthreads();
#ifndef NSA_NO_CMP
        const int tlmax = (4 * qt + 2) >> 6;
#pragma unroll
        for (int qs = 0; qs < 2; ++qs) {
            f32x4 sc[4][4];
            float mx = -1e30f;
#pragma unroll
            for (int tl = 0; tl < 4; ++tl) {
                if (tl <= tlmax) {
#pragma unroll
                    for (int s = 0; s < 4; ++s) {
                        const LAS unsigned char* kp = lds + kcl_off + (tl * 64 + s * 16) * 144;
                        const bf16x8 k0 = *(const LAS bf16x8*)kp, k1 = *(const LAS bf16x8*)(kp + 64);
                        const float cb = slope * (float)((tl * 1024 + s * 256 + 64 * g4 + 31) - tq[qs]);
                        f32x4 zz;
#pragma unroll
                        for (int i = 0; i < 4; ++i) zz[i] = fmaf(slope, 16.f * (float)i, cb);
                        zz = MFMA16(k0, Qf[qs][0], zz);
                        zz = MFMA16(k1, Qf[qs][1], zz);
                        if (!((64 * (tl + 1) - 1) <= (4 * qt - 2))) {
#pragma unroll
                            for (int i = 0; i < 4; ++i) {
                                const int dist = (tq[qs] - 31 - 64 * g4) - (tl * 1024 + s * 256 + 16 * i);
                                const bool ok = (dist >= 0) && !(tl == 3 && s == 3 && i == 3 && g4 == 3);
                                zz[i] = ok ? zz[i] : -1e30f;
                            }
                        }
#pragma unroll
                        for (int i = 0; i < 4; ++i) mx = fmaxf(mx, zz[i]);
                        sc[tl][s] = zz;
                        __builtin_amdgcn_sched_barrier(0);
                    }
                } else {
#pragma unroll
                    for (int s = 0; s < 4; ++s) sc[tl][s] = (f32x4){-1e30f, -1e30f, -1e30f, -1e30f};
                }
            }
            mx = fmaxf(mx, __shfl_xor(mx, 16)); mx = fmaxf(mx, __shfl_xor(mx, 32));
            const float mxx = fmaxf(mx, -1e29f);
            float ps = 0.f;
#pragma unroll
            for (int tl = 0; tl < 4; ++tl) {
                if (tl <= tlmax) {
#pragma unroll
                    for (int s = 0; s < 4; ++s)
#pragma unroll
                        for (int i = 0; i < 4; ++i) { const float p = __builtin_amdgcn_exp2f(sc[tl][s][i] - mxx); sc[tl][s][i] = p; ps += p; }
                } else {
#pragma unroll
                    for (int s = 0; s < 4; ++s) sc[tl][s] = (f32x4){0.f, 0.f, 0.f, 0.f};
                }
            }
            ps += __shfl_xor(ps, 16); ps += __shfl_xor(ps, 32);
            const float inv = ps > 0.f ? 1.f / ps : 0.f;
            unsigned imp_off = (unsigned)((hr * 64 + qh * 32 + qs * 16 + l15) * 65 + g4) * 4u; asm volatile("" : "+v"(imp_off));
            LAS float* impw = (LAS float*)(lds + NS_IMP + imp_off);
            float prev3 = 0.f;
#pragma unroll
            for (int tl = 0; tl < 4; ++tl) {
                if (tl <= tlmax) {
#pragma unroll
                    for (int s = 0; s < 4; ++s) {
                        f32x4 p = sc[tl][s] * inv; sc[tl][s] = p;
                        const float from_same = __shfl(p[3], (lane + 48) & 63);
                        const float from_prev = __shfl(prev3, (lane + 48) & 63);
                        const float p3m = (g4 > 0) ? from_same : from_prev;
                        impw[tl * 16 + s * 4] = p3m + 2.f * (p[0] + p[1] + p[2]) + p[3];
                        prev3 = p[3];
                    }
                } else {
#pragma unroll
                    for (int s = 0; s < 4; ++s) {
                        const float from_prev = __shfl(prev3, (lane + 48) & 63);
                        impw[tl * 16 + s * 4] = (g4 > 0) ? 0.f : from_prev;
                        prev3 = 0.f;
                    }
                }
            }
            f32x4 Oc[4];
#pragma unroll
            for (int d = 0; d < 4; ++d) Oc[d] = (f32x4){0.f, 0.f, 0.f, 0.f};
#pragma unroll
            for (int kk = 0; kk < 8; ++kk) {
                const int tl = kk >> 1, s0 = (kk & 1) * 2;
                if (tl <= tlmax) {
                    u32x4 w; w.x = pk2(sc[tl][s0][0], sc[tl][s0][1]); w.y = pk2(sc[tl][s0][2], sc[tl][s0][3]); w.z = pk2(sc[tl][s0 + 1][0], sc[tl][s0 + 1][1]); w.w = pk2(sc[tl][s0 + 1][2], sc[tl][s0 + 1][3]);
                    const bf16x8 Pf = __builtin_bit_cast(bf16x8, w);
#pragma unroll
                    for (int d = 0; d < 4; ++d) {
                        const LAS unsigned char* vp = lds + vcl_off + (d * 16) * 528 + (kk * 32) * 2;
                        const s16x4 lo = *(const LAS s16x4*)vp, hi = *(const LAS s16x4*)(vp + 32);
                        const bf16x8 Vf = {lo[0], lo[1], lo[2], lo[3], hi[0], hi[1], hi[2], hi[3]};
                        Oc[d] = MFMA16(Vf, Pf, Oc[d]);
                    }
                    __builtin_amdgcn_sched_barrier(0);
                }
            }
#pragma unroll
            for (int d = 0; d < 4; ++d) Y[d][qs] = Y[d][qs] + Oc[d] * gate[qs][0];
        }
#endif
        __syncthreads();
#ifndef NSA_NO_TOPK
        for (int qi = 0; qi < 8; ++qi) {
            const int q = wid * 8 + qi, j = lane;
            const float imp = ((IMP[(0 * 64 + q) * 65 + j] + IMP[(1 * 64 + q) * 65 + j]) + IMP[(2 * 64 + q) * 65 + j]) + IMP[(3 * 64 + q) * 65 + j];
            const bool forced = (j == 0) || (j == cur) || (j == cur - 1);
            const bool valid = (j <= cur);
            unsigned key = forced ? 0xFFFFFFC0u : (valid ? (__float_as_uint(fmaxf(imp, 0.f)) & 0xFFFFFFC0u) : 0u);
            key |= (unsigned)(63 - j);
            int rank = 0;
#pragma unroll 8
            for (int jp = 0; jp <= cur; ++jp) { const unsigned kj = (unsigned)__builtin_amdgcn_readlane((int)key, jp); rank += (kj > key) ? 1 : 0; }
            const unsigned long long mk = __ballot((rank < 16) && valid);
            if (lane == 0) { SELM[2 * q] = (unsigned)mk; SELM[2 * q + 1] = (unsigned)(mk >> 32); atomicOr((unsigned*)&UNI[0], (unsigned)mk); atomicOr((unsigned*)&UNI[1], (unsigned)(mk >> 32)); }
        }
#endif
        __syncthreads();
        const unsigned long long uni = ((unsigned long long)(unsigned)__builtin_amdgcn_readfirstlane((int)UNI[1]) << 32) | (unsigned)__builtin_amdgcn_readfirstlane((int)UNI[0]);
        unsigned long long msk[2];
#pragma unroll
        for (int qs = 0; qs < 2; ++qs) { const int ql = qh * 32 + qs * 16 + l15; msk[qs] = ((unsigned long long)SELM[2 * ql + 1] << 32) | SELM[2 * ql]; }
#ifndef NSA_NO_SEL
        {
            f32x4 O[4][2]; float mrun[2] = {-1e30f, -1e30f}, lrun[2] = {0.f, 0.f};
#pragma unroll
            for (int d = 0; d < 4; ++d) { O[d][0] = (f32x4){0.f, 0.f, 0.f, 0.f}; O[d][1] = O[d][0]; }
            unsigned long long rem = uni & ((cur >= 63) ? ~0ull : ((2ull << cur) - 1ull));
            u32x4 pkv = {0u, 0u, 0u, 0u}, pvv = pkv;
            int j = -1;
            if (rem) { j = __builtin_ctzll(rem); rem &= rem - 1ull;
                nsa_fetch(pkv, pvv, z + ((size_t)b * SEQ + j * 64) * ZLD + ZKS + g * 64, ZLD, VST + ((size_t)(b * 128 + g * 64)) * SEQ + j * 64, SEQ, tidv); }
            while (j >= 0) {
                __syncthreads();
                nsa_commit(lds, pkv, pvv, tidv);
                __syncthreads();
                const int jc = j;
                if (rem) { j = __builtin_ctzll(rem); rem &= rem - 1ull;
                    nsa_fetch(pkv, pvv, z + ((size_t)b * SEQ + j * 64) * ZLD + ZKS + g * 64, ZLD, VST + ((size_t)(b * 128 + g * 64)) * SEQ + j * 64, SEQ, tidv); }
                else j = -1;
                const bool selb[2] = {(bool)((msk[0] >> jc) & 1ull), (bool)((msk[1] >> jc) & 1ull)};
                flash_tile<1>(lds, kt_off, vt_off, Qf, O, mrun, lrun, slope, tq, jc * 64, selb, l15, g4, jc < cur);
            }
#pragma unroll
            for (int qs = 0; qs < 2; ++qs) {
                float l = lrun[qs]; l += __shfl_xor(l, 16); l += __shfl_xor(l, 32);
                const float sc1 = l > 0.f ? gate[qs][1] / l : 0.f;
#pragma unroll
                for (int d = 0; d < 4; ++d) Y[d][qs] = Y[d][qs] + O[d][qs] * sc1;
            }
        }
#endif
#ifndef NSA_NO_WIN
        {
            f32x4 O[4][2]; float mrun[2] = {-1e30f, -1e30f}, lrun[2] = {0.f, 0.f};
#pragma unroll
            for (int d = 0; d < 4; ++d) { O[d][0] = (f32x4){0.f, 0.f, 0.f, 0.f}; O[d][1] = O[d][0]; }
            const bool selb[2] = {true, true};
            u32x4 pkv, pvv;
            int j = (cur > 8 ? cur - 8 : 0);
            nsa_fetch(pkv, pvv, z + ((size_t)b * SEQ + j * 64) * ZLD + ZKW + g * 64, ZLD, VWT + ((size_t)(b * 128 + g * 64)) * SEQ + j * 64, SEQ, tidv);
            for (; j <= cur; ++j) {
                __syncthreads();
                nsa_commit(lds, pkv, pvv, tidv);
                __syncthreads();
                if (j < cur) nsa_fetch(pkv, pvv, z + ((size_t)b * SEQ + (j + 1) * 64) * ZLD + ZKW + g * 64, ZLD, VWT + ((size_t)(b * 128 + g * 64)) * SEQ + (j + 1) * 64, SEQ, tidv);
                flash_tile<2>(lds, kt_off, vt_off, Qf, O, mrun, lrun, slope, tq, j * 64, selb, l15, g4, (j < cur) && (j > cur - 8));
            }
#pragma unroll
            for (int qs = 0; qs < 2; ++qs) {
                float l = lrun[qs]; l += __shfl_xor(l, 16); l += __shfl_xor(l, 32);
                const float sc2 = l > 0.f ? gate[qs][2] / l : 0.f;
#pragma unroll
                for (int d = 0; d < 4; ++d) Y[d][qs] = Y[d][qs] + O[d][qs] * sc2;
            }
        }
#endif
#pragma unroll
        for (int qs = 0; qs < 2; ++qs) {
            bf16_t* op = A2 + (row0 + qh * 32 + qs * 16 + l15) * (size_t)ldo + hq * 64 + 4 * g4;
#pragma unroll
            for (int d = 0; d < 4; ++d) { u32x2 w; w.x = pk2(Y[d][qs][0], Y[d][qs][1]); w.y = pk2(Y[d][qs][2], Y[d][qs][3]); *(u32x2*)(op + d * 16) = w; }
        }
    }
}

__device__ __forceinline__ void rwkv_post(const Args& a, const bf16_t* z, const bf16_t* lo, const float* yraw, bf16_t* A2, const bf16_t* A2N) {
    const int tid = threadIdx.x, c8 = (tid & 7) * 8, h = (tid >> 3) & 7, tk = tid >> 6, hc = h * 64 + c8;
    float mur[8], muk[8], muv[8], a0v[8], kav[8], rkv[8], lw[8], lb[8];
#pragma unroll
    for (int i = 0; i < 8; ++i) { mur[i] = a.in[16][hc + i]; muk[i] = a.in[16][512 + hc + i]; muv[i] = a.in[16][1024 + hc + i];
        a0v[i] = a.in[19][hc + i]; kav[i] = a.in[23][hc + i]; rkv[i] = a.in[24][hc + i]; lw[i] = a.in[25][hc + i]; lb[i] = a.in[26][hc + i]; }
    u32x4 ncr, nck, ncv, npr, npk, npv, nla, nlg, nyw, nan_ = {0u, 0u, 0u, 0u};
#define PP_LOAD(it_) do { const size_t row_ = (size_t)(it_) * 8 + tk; const int t_ = (int)(row_ & (SEQ - 1)); const bf16_t* zr_ = z + row_ * ZLD; \
        ncr = *(const u32x4*)(zr_ + ZR + hc); nck = *(const u32x4*)(zr_ + ZK + hc); ncv = *(const u32x4*)(zr_ + ZV + hc); \
        npr = (u32x4){0u, 0u, 0u, 0u}; npk = npr; npv = npr; \
        if (t_ > 0) { const bf16_t* zp_ = zr_ - ZLD; npr = *(const u32x4*)(zp_ + ZR + hc); npk = *(const u32x4*)(zp_ + ZK + hc); npv = *(const u32x4*)(zp_ + ZV + hc); } \
        nla = *(const u32x4*)(lo + row_ * 1536 + 512 + hc); nlg = *(const u32x4*)(lo + row_ * 1536 + 1024 + hc); \
        nyw = *(const u32x4*)((const bf16_t*)yraw + row_ * 512 + hc); if (A2N) nan_ = *(const u32x4*)(A2N + row_ * 512 + hc); } while (0)
    if ((int)blockIdx.x < NTOK / 8) PP_LOAD(blockIdx.x);
    for (int it = blockIdx.x; it < NTOK / 8; it += gridDim.x) {
        const size_t row = (size_t)it * 8 + tk;
        const u32x4 cr = ncr, ck = nck, cv = ncv, pr = npr, pk = npk, pv = npv, la = nla, lg = nlg, yw = nyw, an = nan_;
        if (it + (int)gridDim.x < NTOK / 8) PP_LOAD(it + (int)gridDim.x);
        float fr_[8], fk[8], fv[8], gr[8], gk[8], gv[8], fla[8], fg[8];
        unpack8(cr, fr_); unpack8(ck, fk); unpack8(cv, fv); unpack8(pr, gr); unpack8(pk, gk); unpack8(pv, gv); unpack8(la, fla); unpack8(lg, fg);
        float y[8]; unpack8(yw, y);
        if (A2N) *(u32x4*)(A2 + row * DM + hc) = an;
        float bon = 0.f, sm = 0.f;
#pragma unroll
        for (int i = 0; i < 8; ++i) {
            fr_[i] = fr_[i] + (gr[i] - fr_[i]) * mur[i]; fk[i] = fk[i] + (gk[i] - fk[i]) * muk[i]; fv[i] = fv[i] + (gv[i] - fv[i]) * muv[i];
            const float av = sigm(a0v[i] + fla[i]);
            const float k2 = fk[i] * (1.f + (av - 1.f) * kav[i]);
            bon += fr_[i] * k2 * rkv[i]; sm += y[i];
        }
        bon += __shfl_xor(bon, 1); bon += __shfl_xor(bon, 2); bon += __shfl_xor(bon, 4);
        sm += __shfl_xor(sm, 1); sm += __shfl_xor(sm, 2); sm += __shfl_xor(sm, 4);
        const float mean = sm * (1.f / 64.f);
        float vs = 0.f;
#pragma unroll
        for (int i = 0; i < 8; ++i) { const float d = y[i] - mean; vs += d * d; }
        vs += __shfl_xor(vs, 1); vs += __shfl_xor(vs, 2); vs += __shfl_xor(vs, 4);
        const float rstd = rsqrtf(vs * (1.f / 64.f) + GN_EPS);
        float o[8];
#pragma unroll
        for (int i = 0; i < 8; ++i) o[i] = ((y[i] - mean) * rstd * lw[i] + lb[i] + bon * fv[i]) * fg[i];
        *(u32x4*)(A2 + row * DM + 512 + hc) = pack8(o);
    }
}

template <bool BASE_BF16>
__device__ __forceinline__ void row_pass(const void* base, const bf16_t* src, const float* psq, const float* gain, bf16_t* xb, float* rs_out, int gw, int NGW, int lane) {
    f32x4 gn[4];
#pragma unroll
    for (int j = 0; j < 4; ++j) gn[j] = *(const f32x4*)(gain + 4 * lane + 256 * j);
    f32x4 xa[4]; u32x2 sa[4]; float pa = 0.f;
#define RP_LOAD(m_, xv_, sv_, pq_) do { _Pragma("unroll") for (int j = 0; j < 4; ++j) { const size_t off = (size_t)(m_) * DM + 4 * lane + 256 * j; \
        if (BASE_BF16) { const u32x2 bw = *(const u32x2*)((const bf16_t*)base + off); xv_[j] = (f32x4){bf_lo(bw.x), bf_hi(bw.x), bf_lo(bw.y), bf_hi(bw.y)}; } \
        else xv_[j] = *(const f32x4*)((const float*)base + off); \
        sv_[j] = *(const u32x2*)(src + off); } \
        pq_ = (lane < 16) ? psq[(size_t)(m_) * 16 + lane] : 0.f; } while (0)
    if (gw < NTOK) RP_LOAD(gw, xa, sa, pa);
    for (int m = gw; m < NTOK; m += NGW) {
        f32x4 xn[4]; u32x2 sn[4]; float pn = 0.f;
        if (m + NGW < NTOK) RP_LOAD(m + NGW, xn, sn, pn);
        const float s = wave_sum(pa);
        const float rsm = rsqrtf(s * (1.f / DM) + NORM_EPS);
        float ss = 0.f;
#pragma unroll
        for (int j = 0; j < 4; ++j) {
            const size_t off = (size_t)m * DM + 4 * lane + 256 * j;
            const f32x4 sv = {bf_lo(sa[j].x), bf_hi(sa[j].x), bf_lo(sa[j].y), bf_hi(sa[j].y)};
            const f32x4 o = xa[j] + sv * rsm * gn[j];
            ss += o[0] * o[0] + o[1] * o[1] + o[2] * o[2] + o[3] * o[3];
            u32x2 w; w.x = pk2(o[0], o[1]); w.y = pk2(o[2], o[3]);
            *(u32x2*)(xb + off) = w;
        }
        if (rs_out) { ss = wave_sum(ss); if (lane == 0) rs_out[m] = rsqrtf(ss * (1.f / DM) + NORM_EPS); }
#pragma unroll
        for (int j = 0; j < 4; ++j) { xa[j] = xn[j]; sa[j] = sn[j]; }
        pa = pn;
    }
#undef RP_LOAD
}

#define XB_TMO      128
#define XB_XCNT(j)  (256  + 64 * (j))
#define XB_XSUB(j)  (1280 + 64 * (j))
#define XB_XGEN(j)  (2304 + 64 * (j))
#define XB_TOP      3328
#define XB_TOPGEN   3392
#define XCD_BAR_WORDS 3456
#define XB_SPIN_CAP (1u << 18)

__device__ __forceinline__ unsigned xb_ld(unsigned* p)              { return __hip_atomic_load(p, __ATOMIC_RELAXED, __HIP_MEMORY_SCOPE_AGENT); }
__device__ __forceinline__ unsigned xb_add(unsigned* p, unsigned v) { return __hip_atomic_fetch_add(p, v, __ATOMIC_RELAXED, __HIP_MEMORY_SCOPE_AGENT); }
__device__ __forceinline__ unsigned xb_xcc_id() { return (unsigned)__builtin_amdgcn_s_getreg((3 << 11) | 20) & 0xFu; }
#define XB_SPIN(cond, bar) do { unsigned _sp = 0; while (cond) { __builtin_amdgcn_s_sleep(1); \
    if ((++_sp & 255u) == 0u) { if (xb_ld(&(bar)[XB_TMO])) break; if (_sp > XB_SPIN_CAP) { atomicAdd(&(bar)[XB_TMO], 1u); break; } } } } while (0)

struct XcdBarrier {
    unsigned* bar; unsigned x;
    volatile LAS unsigned* st;
};

__device__ __forceinline__ XcdBarrier xcd_barrier_post(unsigned* bar, volatile LAS unsigned* st) {
    XcdBarrier b; b.bar = bar; b.x = xb_xcc_id(); b.st = st;
    if (threadIdx.x == 0) (void)xb_add(&bar[XB_XCNT(b.x)], 1u);
    return b;
}
__device__ __forceinline__ void xcd_barrier_complete(unsigned* bar, unsigned x, unsigned& nloc, unsigned& nx) {
    const unsigned G = gridDim.x * gridDim.y * gridDim.z;
    unsigned sum, cnt, mine, sp = 0u;
    for (;;) {
        sum = 0u; cnt = 0u; mine = 0u;
#pragma unroll
        for (unsigned j = 0; j < 16; ++j) { const unsigned c = xb_ld(&bar[XB_XCNT(j)]); sum += c; cnt += (c > 0u) ? 1u : 0u; mine = (j == x) ? c : mine; }
        if (sum == G) break;
        __builtin_amdgcn_s_sleep(1);
        if ((++sp & 255u) == 0u) { if (xb_ld(&bar[XB_TMO])) break; if (sp > XB_SPIN_CAP) { atomicAdd(&bar[XB_TMO], 1u); break; } }
    }
    nloc = mine > 0u ? mine : 1u; nx = cnt > 0u ? cnt : 1u;
}

__device__ __forceinline__ void xcd_barrier(const XcdBarrier& b) {
    asm volatile("s_waitcnt vmcnt(0)" ::: "memory");
    __syncthreads();
    if (threadIdx.x == 0) {
        unsigned* bar = b.bar;
        __builtin_amdgcn_s_waitcnt(0);
        unsigned nloc = b.st[0], nx = b.st[1];
        if (nloc == 0u) { xcd_barrier_complete(bar, b.x, nloc, nx); b.st[0] = nloc; b.st[1] = nx; }
        const unsigned old = xb_add(&bar[XB_XSUB(b.x)], 1u);
        const unsigned gen = old / nloc;
        if (old + 1u == (gen + 1u) * nloc) {
            __builtin_amdgcn_fence(__ATOMIC_RELEASE, "agent");
            asm volatile("s_waitcnt vmcnt(0)" ::: "memory");
            const unsigned og = xb_add(&bar[XB_TOP], 1u);
            const unsigned tg = og / nx;
            if (og + 1u == (tg + 1u) * nx) xb_add(&bar[XB_TOPGEN], 1u);
            else XB_SPIN(xb_ld(&bar[XB_TOPGEN]) == tg, bar);
            __builtin_amdgcn_fence(__ATOMIC_ACQUIRE, "agent");
            xb_add(&bar[XB_XGEN(b.x)], 1u);
            asm volatile("s_waitcnt vmcnt(0)" ::: "memory");
        } else {
            XB_SPIN(xb_ld(&bar[XB_XGEN(b.x)]) == gen, bar);
            __builtin_amdgcn_fence(__ATOMIC_ACQUIRE, "agent");
            asm volatile("s_waitcnt vmcnt(0)" ::: "memory");
        }
    }
    __syncthreads();
}

__global__ void __launch_bounds__(512, 2) hymba_fwd(Args a) {
    extern __shared__ __attribute__((aligned(16))) unsigned char lds_raw[];
    LAS unsigned char* lds = (LAS unsigned char*)lds_raw;
    cg::grid_group grid = cg::this_grid();
    const int tid = threadIdx.x, lane = tid & 63, wid = __builtin_amdgcn_readfirstlane(tid >> 6);
    const int G = gridDim.x, bx = blockIdx.x, gw = bx * 8 + wid, NGW = G * 8;
    unsigned char* ws = a.ws;
    bf16_t* WIN_T = (bf16_t*)(ws + WS_WIN); bf16_t* WOUT_T = (bf16_t*)(ws + WS_WOUT); bf16_t* WUP_T = (bf16_t*)(ws + WS_WUP); bf16_t* WDN_T = (bf16_t*)(ws + WS_WDN);
    bf16_t* WPLE_T = (bf16_t*)(ws + WS_WPLE); bf16_t* WPG_T = (bf16_t*)(ws + WS_WPG);
    bf16_t* CK1_T = (bf16_t*)(ws + WS_CK1); bf16_t* CV1_T = (bf16_t*)(ws + WS_CV1); bf16_t* CK2_T = (bf16_t*)(ws + WS_CK2); bf16_t* CV2_T = (bf16_t*)(ws + WS_CV2); bf16_t* LORA_T = (bf16_t*)(ws + WS_LORAT);
    float* BIAS1 = (float*)(ws + WS_BIAS1); float* RS1 = (float*)(ws + WS_RS1); float* RS2 = (float*)(ws + WS_RS2); float* PSQ = (float*)(ws + WS_PSQ);
    bf16_t* CHK = (bf16_t*)(ws + WS_CHK); bf16_t* CHV = (bf16_t*)(ws + WS_CHV); bf16_t* KC = (bf16_t*)(ws + WS_KC); bf16_t* VCT = (bf16_t*)(ws + WS_VCT);
    bf16_t* VST = (bf16_t*)(ws + WS_VST); bf16_t* VWT = (bf16_t*)(ws + WS_VWT);
    bf16_t* PB = (bf16_t*)(ws + WS_PB); bf16_t* LORA_A = (bf16_t*)(ws + WS_LORAA);
    bf16_t* RB = (bf16_t*)(ws + WS_RB); bf16_t* RC = (bf16_t*)(ws + WS_RC); bf16_t* RA = (bf16_t*)(ws + WS_RA);
    bf16_t* Z = RA; bf16_t* LORA_O = (bf16_t*)a.out;
    const int lo = a.ph_lo, hi = a.ph_hi;
#ifndef PHMASK
#define PHMASK 0xFFF
#endif
#define IN(k) (((PHMASK >> (k)) & 1) && lo <= (k) && (k) < hi)
    volatile LAS unsigned* xst = (volatile LAS unsigned*)(lds + LDS_BYTES - 16);
    if (tid == 0) { xst[0] = 0u; xst[1] = 0u; }
    __syncthreads();
    if (bx == 0) for (int i = tid; i < 4096; i += 512) ((unsigned*)ws)[i] = 0u;
    grid.sync();
    const XcdBarrier xbar = xcd_barrier_post((unsigned*)ws, xst);
#define SEAM(k) do { if (IN(k) && IN((k) + 1)) xcd_barrier(xbar); } while (0)
    const Epi<0> proto0{nullptr, 0, nullptr, nullptr, nullptr, nullptr, nullptr, nullptr};
    (void)proto0;

    if (IN(0)) {
        LAS float* scr = (LAS float*)(lds + wid * 16384);
        const float* w_in = a.in[6];
        tr_matrix(w_in, 1024, 3096, 0, 512, WIN_T, 1024, 0, 0, a.in[2], 0.125f * 1.4426950408889634f, scr, gw, NGW, lane);
        tr_matrix(w_in, 1024, 3096, 512, 384, WIN_T, 1024, 512, 0, a.in[2], 1.f, scr, gw, NGW, lane);
        tr_matrix(w_in, 1024, 3096, 896, 128, WIN_T, 1024, ZVS, 0, a.in[2], 1.f, scr, gw, NGW, lane);
        tr_matrix(w_in, 1024, 3096, 1024, 128, WIN_T, 1024, ZKW, 0, a.in[2], 1.f, scr, gw, NGW, lane);
        tr_matrix(w_in, 1024, 3096, 1152, 128, WIN_T, 1024, ZVW, 0, a.in[2], 1.f, scr, gw, NGW, lane);
        tr_matrix(w_in, 1024, 3096, 1280, 24, WIN_T, 1024, ZGT, 0, a.in[2], 1.f, scr, gw, NGW, lane);
        tr_matrix(w_in, 1024, 3096, 1304, 1792, WIN_T, 1024, ZR, 0, a.in[2], 1.f, scr, gw, NGW, lane);
        tr_matrix(a.in[27], 1024, 1024, 0, 1024, WOUT_T, 1024, 0, 0, nullptr, 1.f, scr, gw, NGW, lane);
        tr_matrix(a.in[28], 1024, 4096, 0, 4096, WUP_T, 1024, 0, 0, a.in[4], 1.f, scr, gw, NGW, lane);
        tr_matrix(a.in[29], 4096, 1024, 0, 1024, WDN_T, 4096, 0, 0, nullptr, 1.f, scr, gw, NGW, lane);
        tr_matrix(a.in[30], 256, 1024, 0, 1024, WPLE_T, 256, 0, 0, nullptr, 1.f, scr, gw, NGW, lane);
        tr_matrix(a.in[31], 1024, 1024, 0, 1024, WPG_T, 1024, 0, 0, nullptr, 1.f, scr, gw, NGW, lane);
        tr_matrix(a.in[9], 2048, 128, 0, 128, CK1_T, 2048, 0, 0, nullptr, 1.f, scr, gw, NGW, lane);
        tr_matrix(a.in[13], 2048, 128, 0, 128, CV1_T, 2048, 0, 0, nullptr, 1.f, scr, gw, NGW, lane);
        tr_matrix(a.in[11], 128, 64, 0, 64, CK2_T, 256, 0, 0, nullptr, 1.f, scr, gw, NGW, lane);
        tr_matrix(a.in[15], 128, 64, 0, 64, CV2_T, 256, 0, 0, nullptr, 1.f, scr, gw, NGW, lane);
        tr_matrix(a.in[18], 64, 512, 0, 512, LORA_T, 256, 0, 0, nullptr, 1.f, scr, gw, NGW, lane);
        tr_matrix(a.in[20], 64, 512, 0, 512, LORA_T, 256, 512, 64, nullptr, 1.f, scr, gw, NGW, lane);
        tr_matrix(a.in[21], 128, 512, 0, 512, LORA_T, 256, 1024, 128, nullptr, 1.f, scr, gw, NGW, lane);
        for (int i = bx * 512 + tid; i < 1536 * 32 + 2 * 64 * 16; i += G * 512) {
            if (i < 1536 * 32) { const int row = i >> 5, c8 = i & 31; const int lo8 = row < 512 ? 0 : (row < 1024 ? 8 : 16), hi8 = row < 512 ? 8 : (row < 1024 ? 16 : 32);
                if (c8 < lo8 || c8 >= hi8) *(u32x4*)(LORA_T + (size_t)row * 256 + c8 * 8) = (u32x4){0u, 0u, 0u, 0u}; }
            else { const int k = i - 1536 * 32, which = k >> 10, row = (k >> 4) & 63, c8 = 16 + (k & 15);
                *(u32x4*)((which ? CV2_T : CK2_T) + (size_t)row * 256 + c8 * 8) = (u32x4){0u, 0u, 0u, 0u}; }
        }
        if (gw < 256) {
            const int which = gw >> 7, n = gw & 127;
            const float* pe = which ? a.in[12] : a.in[8]; const float* w1 = which ? a.in[13] : a.in[9]; const float* b1 = which ? a.in[14] : a.in[10];
            float s = 0.f;
            for (int k = lane; k < 2048; k += 64) s += pe[k] * w1[(size_t)k * 128 + n];
            s = wave_sum(s);
            if (lane == 0) { BIAS1[which * 256 + n] = s + b1[n]; BIAS1[which * 256 + 128 + n] = 0.f; }
        }
        bf16_t* XB = RB;
        f32x4 vn[4];
        if (gw < NTOK) { const f32x4* xr0 = (const f32x4*)(a.in[0] + (size_t)gw * DM) + lane;
#pragma unroll
            for (int j = 0; j < 4; ++j) vn[j] = xr0[64 * j]; }
        for (int m = gw; m < NTOK; m += NGW) {
            f32x4 v[4]; float s = 0.f;
#pragma unroll
            for (int j = 0; j < 4; ++j) v[j] = vn[j];
            if (m + NGW < NTOK) { const f32x4* xr1 = (const f32x4*)(a.in[0] + (size_t)(m + NGW) * DM) + lane;
#pragma unroll
                for (int j = 0; j < 4; ++j) vn[j] = xr1[64 * j]; }
#pragma unroll
            for (int j = 0; j < 4; ++j) s += (v[j][0] * v[j][0] + v[j][1] * v[j][1]) + (v[j][2] * v[j][2] + v[j][3] * v[j][3]);
            s = wave_sum(s);
            if (lane == 0) RS1[m] = rsqrtf(s * (1.f / DM) + NORM_EPS);
            u32x2* o8 = (u32x2*)(XB + (size_t)m * DM) + lane;
#pragma unroll
            for (int j = 0; j < 4; ++j) { u32x2 w; w.x = pk2(v[j][0], v[j][1]); w.y = pk2(v[j][2], v[j][3]); o8[64 * j] = w; }
        }
        for (size_t i = (size_t)bx * 512 + tid; i < (size_t)NTOK * 256 / 8; i += (size_t)G * 512) {
            const f32x4 p0 = *(const f32x4*)(a.in[1] + i * 8), p1 = *(const f32x4*)(a.in[1] + i * 8 + 4);
            u32x4 w; w.x = pk2(p0[0], p0[1]); w.y = pk2(p0[2], p0[3]); w.z = pk2(p1[0], p1[1]); w.w = pk2(p1[2], p1[3]);
            *(u32x4*)(PB + i * 8) = w;
        }
    }
    SEAM(0);
    if (IN(1)) {
        Epi<0> E{Z, ZLD, RS1, nullptr, nullptr, VST, nullptr, nullptr};
        run_gemm<0>(lds, RB, WIN_T, NTOK, ZLD, 1024, 1024, 128, 0, bx, E);
    }
    SEAM(1);
    if (IN(2)) {
        { Epi<1> E{CHK, 256, nullptr, BIAS1, nullptr, nullptr, nullptr, nullptr};
          run_gemm<1>(lds, Z + ZKC, CK1_T, 8192, 256, 2048, 16 * ZLD, (long)ZLD * 2, 1, bx, E); }
        { Epi<1> E{CHV, 256, nullptr, BIAS1 + 256, nullptr, nullptr, nullptr, nullptr};
          run_gemm<1>(lds, Z + ZVC, CV1_T, 8192, 256, 2048, 16 * ZLD, (long)ZLD * 2, 1, (bx + G / 2) % G, E); }
        const float* mu = a.in[16] + 1536;
        const bool has_cmp = (G == 256) && (bx < 32 || (bx >= 128 && bx < 160));
        const int eb = (G == 256) ? (bx < 128 ? bx - 32 : bx - 64) : bx, eG = (G == 256) ? 192 : G;
        if (!has_cmp)
        for (size_t i = (size_t)eb * 512 + tid; i < (size_t)NTOK * 32; i += (size_t)eG * 512) {
            const size_t row = i >> 5; const int col = (int)(i & 31) * 8; const int t = (int)(row & (SEQ - 1));
            const bf16_t* zr = Z + row * ZLD + ZWD + col;
            const u32x4 cw = *(const u32x4*)zr; u32x4 pw = {0u, 0u, 0u, 0u};
            if (t > 0) pw = *(const u32x4*)(zr - ZLD);
            float c[8], p[8]; unpack8(cw, c); unpack8(pw, p);
#pragma unroll
            for (int j = 0; j < 8; ++j) {
                float v = c[j] + (p[j] - c[j]) * mu[col + j];
                if (col < 64) { const float e = __expf(2.f * v); v = 1.f - 2.f / (e + 1.f); }
                else if (col >= 128) v = sigm(v);
                c[j] = v;
            }
            *(u32x4*)(LORA_A + row * 256 + col) = pack8(c);
        }
    }
    SEAM(2);
    if (IN(3)) {
#ifndef P3_SKIP1
        { Epi<2> E{LORA_O, 1536, nullptr, nullptr, nullptr, nullptr, nullptr, nullptr};
          run_gemm<2>(lds, LORA_A, LORA_T, NTOK, 1536, 256, 256, 128, 0, bx, E); }
#endif
#ifndef P3_SKIP2
        { Epi<2> E{KC, 256, nullptr, nullptr, nullptr, nullptr, nullptr, nullptr};
          run_gemm<2>(lds, CHK, CK2_T, 8192, 256, 256, 256, 128, 0, bx, E); }
#endif
#ifndef P3_SKIP3
        { Epi<3> E{nullptr, 0, nullptr, nullptr, nullptr, VCT, nullptr, nullptr};
          run_gemm<3>(lds, CHV, CV2_T, 8192, 256, 256, 256, 128, 0, (bx + G / 2) % G, E); }
#endif
    }
    SEAM(3);
#ifndef REP4
#define REP4 1
#endif
#ifndef REP5
#define REP5 1
#endif
    const bool merged45 = (G == 256) && IN(4) && IN(5);
    bf16_t* A2N = RB + (size_t)NTOK * 512;
    if (IN(4)) { scan_precompute(lds, a, Z, LORA_O); xcd_barrier(xbar); scan_phase(lds, a, Z, LORA_O, (float*)RB);
                 if (merged45) nsa_phase(lds, a, Z, KC, VCT, VST, VWT, A2N, 512, true); }
    SEAM(4);
    if (IN(5)) for (int rep = 0; rep < REP5; ++rep) {
#ifndef NO_NSA
        if (!merged45) nsa_phase(lds, a, Z, KC, VCT, VST, VWT, RC, DM, false);
#endif
#ifndef NO_POST
        rwkv_post(a, Z, LORA_O, (const float*)RB, RC, merged45 ? A2N : (const bf16_t*)nullptr);
#endif
    }
    SEAM(5);
    if (IN(6)) {
        Epi<4> E{RB, DM, nullptr, nullptr, PSQ, nullptr, nullptr, nullptr};
        run_gemm<4>(lds, RC, WOUT_T, NTOK, DM, DM, DM, 128, 0, bx, E);
    }
    SEAM(6);
    if (IN(7)) row_pass<false>(a.in[0], RB, PSQ, a.in[3], RC, RS2, gw, NGW, lane);
    SEAM(7);
    if (IN(8)) {
        Epi<5> E{RA, DFF, RS2, nullptr, nullptr, nullptr, nullptr, nullptr};
        run_gemm<5>(lds, RC, WUP_T, NTOK, DFF, DM, DM, 128, 0, bx, E);
    }
    SEAM(8);
    if (IN(9)) {
        Epi<4> E{RB, DM, nullptr, nullptr, PSQ, nullptr, nullptr, nullptr};
        run_gemm<4>(lds, RA, WDN_T, NTOK, DM, DFF, DFF, 128, 0, bx, E);
    }
    SEAM(9);
    if (IN(10)) {
        { Epi<2> E{RA, DM, nullptr, nullptr, nullptr, nullptr, nullptr, nullptr};
          run_gemm<2>(lds, PB, WPLE_T, NTOK, DM, 256, 256, 128, 0, bx, E); }
        row_pass<true>(RC, RB, PSQ, a.in[5], RC, nullptr, gw, NGW, lane);
    }
    SEAM(10);
    if (IN(11)) {
        Epi<6> E{RC, DM, nullptr, nullptr, nullptr, nullptr, a.out, RA};
        run_gemm<6>(lds, RC, WPG_T, NTOK, DM, DM, DM, 128, 0, bx, E);
    }
#undef IN
#undef SEAM
}

extern "C" void kernel_launch(void* const* d_in, const int* in_sizes, int n_in, void* d_out, int out_size, void* d_ws, size_t ws_size, hipStream_t stream) {
    static int grid = 0;
    if (grid == 0) {
        if (n_in != 32 || out_size != NTOK * DM || ws_size < (size_t)992 * MiB) { fprintf(stderr, "kernel_launch: unexpected shapes (n_in %d out %d ws %zu)\n", n_in, out_size, ws_size); grid = -1; return; }
        int dev = 0, cus = 0, per_cu = 0;
        hipGetDevice(&dev);
        hipDeviceGetAttribute(&cus, hipDeviceAttributeMultiprocessorCount, dev);
        if (hipFuncSetAttribute((const void*)hymba_fwd, hipFuncAttributeMaxDynamicSharedMemorySize, LDS_BYTES) != hipSuccess) { fprintf(stderr, "kernel_launch: hipFuncSetAttribute failed\n"); grid = -1; return; }
        hipOccupancyMaxActiveBlocksPerMultiprocessor(&per_cu, (const void*)hymba_fwd, 512, LDS_BYTES);
        (void)hipGetLastError();
        if (per_cu < 1) fprintf(stderr, "kernel_launch: occupancy query reports %d blocks per CU\n", per_cu);
        grid = cus;
    }
    if (grid < 0) return;
    Args a{};
    for (int i = 0; i < 32; ++i) a.in[i] = (const float*)d_in[i];
    a.out = (float*)d_out; a.ws = (unsigned char*)d_ws;
#if N_LAUNCH_MODE == 1
    a.ph_lo = 0; a.ph_hi = NPHASE;
    { void* args[] = {&a};
      hipError_t e = hipLaunchCooperativeKernel((const void*)hymba_fwd, dim3(grid), dim3(512), args, LDS_BYTES, stream);
      if (e != hipSuccess) fprintf(stderr, "cooperative launch failed: %s (grid %d)\n", hipGetErrorString(e), grid); }
#else
    for (int ph = 0; ph < NPHASE; ++ph) {
        a.ph_lo = ph; a.ph_hi = ph + 1;
        void* args[] = {&a};
        hipError_t e = hipLaunchCooperativeKernel((const void*)hymba_fwd, dim3(grid), dim3(512), args, LDS_BYTES, stream);
        if (e != hipSuccess) { fprintf(stderr, "launch %d failed: %s (grid %d)\n", ph, hipGetErrorString(e), grid); break; }
    }
#endif
}
```

```cpp
#include <hip/hip_runtime.h>
#include <hip/hip_cooperative_groups.h>
#include <cstdio>
#include <cstdint>
namespace cg = cooperative_groups;

#ifndef N_LAUNCH_MODE
#define N_LAUNCH_MODE 1
#endif

#define LAS __attribute__((address_space(3)))
typedef unsigned short bf16_t;
typedef short bf16x8 __attribute__((ext_vector_type(8)));
typedef short s16x4 __attribute__((ext_vector_type(4)));
typedef float f32x4 __attribute__((ext_vector_type(4)));
typedef float f32x2 __attribute__((ext_vector_type(2)));
typedef unsigned u32x4 __attribute__((ext_vector_type(4)));
typedef unsigned u32x2 __attribute__((ext_vector_type(2)));
typedef __bf16 bf16x2_t __attribute__((ext_vector_type(2)));

constexpr int NTOK = 65536, DM = 1024, SEQ = 4096, ZLD = 3328, DFF = 4096;
constexpr int ZQ = 0, ZKC = 512, ZVC = 640, ZKS = 768, ZKW = 896, ZVS = 1024, ZVW = 1152, ZR = 1280, ZK = 1792, ZV = 2304, ZWD = 2816, ZGT = 3072;
constexpr float NORM_EPS = 1e-6f, GN_EPS = 64e-5f;
constexpr int NPHASE = 12;
constexpr size_t MiB = (size_t)1 << 20;
constexpr size_t WS_WIN = 2 * MiB, WS_WOUT = 9 * MiB, WS_WUP = 11 * MiB, WS_WDN = 19 * MiB, WS_WPLE = 27 * MiB, WS_WPG = 28 * MiB;
constexpr size_t WS_ZERO = 30 * MiB, WS_ZERO_BYTES = 4 * MiB;
constexpr size_t WS_CK1 = 30 * MiB, WS_CV1 = 31 * MiB, WS_CK2 = 32 * MiB, WS_CV2 = 32 * MiB + 128 * 1024, WS_LORAT = 33 * MiB;
constexpr size_t WS_BIAS1 = 34 * MiB, WS_RS1 = 35 * MiB, WS_RS2 = 35 * MiB + 512 * 1024, WS_PSQ = 36 * MiB;
constexpr size_t WS_CHK = 40 * MiB, WS_CHV = 44 * MiB, WS_KC = 48 * MiB, WS_VCT = 52 * MiB, WS_VST = 54 * MiB, WS_VWT = 70 * MiB;
constexpr size_t WS_PB = 86 * MiB, WS_LORAA = 118 * MiB, WS_RB = 150 * MiB, WS_RC = 278 * MiB, WS_RA = 406 * MiB, WS_END = 918 * MiB;
constexpr int LDS_BYTES = 155648;

struct Args { const float* in[32]; float* out; unsigned char* ws; int ph_lo, ph_hi; };

__device__ __forceinline__ unsigned pk2(float lo, float hi) { f32x2 v = {lo, hi}; bf16x2_t b = __builtin_convertvector(v, bf16x2_t); return __builtin_bit_cast(unsigned, b); }
__device__ __forceinline__ bf16_t f2bf(float x) { return (bf16_t)(pk2(x, 0.f) & 0xffffu); }
__device__ __forceinline__ float bf_lo(unsigned w) { return __uint_as_float(w << 16); }
__device__ __forceinline__ float bf_hi(unsigned w) { return __uint_as_float(w & 0xffff0000u); }
__device__ __forceinline__ float bf2f(bf16_t h) { return __uint_as_float((unsigned)h << 16); }
__device__ __forceinline__ float sigm(float x) { return __builtin_amdgcn_rcpf(1.f + __expf(-x)); }
__device__ __forceinline__ void unpack8(const u32x4 w, float (&f)[8]) {
    f[0] = bf_lo(w.x); f[1] = bf_hi(w.x); f[2] = bf_lo(w.y); f[3] = bf_hi(w.y); f[4] = bf_lo(w.z); f[5] = bf_hi(w.z); f[6] = bf_lo(w.w); f[7] = bf_hi(w.w); }
__device__ __forceinline__ u32x4 pack8(const float (&f)[8]) { u32x4 w; w.x = pk2(f[0], f[1]); w.y = pk2(f[2], f[3]); w.z = pk2(f[4], f[5]); w.w = pk2(f[6], f[7]); return w; }
__device__ __forceinline__ float wave_sum(float v) {
#pragma unroll
    for (int o = 1; o < 64; o <<= 1) v += __shfl_xor(v, o);
    return v; }
#define LDS_WAIT() asm volatile("s_waitcnt lgkmcnt(0)" ::: "memory")

namespace pg8 {
constexpr int BM = 256, BK = 64, HALF = 128, HTB = HALF * BK * 2, STAGE_BYTES = 8 * HTB, NXCD = 8, WGM = 8;
__host__ __device__ __forceinline__ int lds_byte(int r, int c) { const int st = (r >> 4) * 2 + (c >> 5), rr = r & 15, cc = c & 31, ob = rr * 64 + cc * 2; return st * 1024 + (ob ^ (((ob >> 9) & 1) << 5)); }
__host__ __device__ __forceinline__ void stage_rc(int b, int& R, int& C) { const int st = b / 1024, sb = b % 1024, swz = sb ^ (((sb >> 9) & 1) << 5); R = (st >> 1) * 16 + swz / 64; C = (st & 1) * 32 + (swz % 64) / 2; }
__host__ __device__ __forceinline__ int perm32(int rho) { const int n = rho >> 4, i = rho & 15; return 8 * (i >> 2) + 4 * n + (i & 3); }

struct Unit { int pm, pn; };
struct Gemm { const bf16_t* A; const bf16_t* Bt; int M, N, K; long lda; long akstep; int amode; };
__device__ __forceinline__ size_t a_unit_off(const Gemm& g, int pm) {
    if (g.amode == 1) return ((size_t)(pm >> 1) * SEQ * ZLD + (size_t)(pm & 1) * 64) * 2;
    return (size_t)pm * BM * (size_t)g.lda * 2; }

struct StaticOrder {
    int nM, nN, nwg, G, c;
    __host__ __device__ void init(int M, int N, int G_, int c_) { nM = M / BM; nN = N / BM; nwg = nM * nN; G = G_; c = c_; }
    __host__ __device__ bool next(int i, Unit& u) const {
        const long L = (long)i * G + c; if (L >= nwg) return false;
        int wgid = (int)L; { const int q = nwg / NXCD, r = nwg % NXCD, xcd = wgid % NXCD, off = wgid / NXCD; wgid = (xcd < r ? xcd * (q + 1) : r * (q + 1) + (xcd - r) * q) + off; }
        const int nig = WGM * nN, gid = wgid / nig, fm = gid * WGM, gsz = (nM - fm) < WGM ? (nM - fm) : WGM;
        u.pm = fm + ((wgid % nig) % gsz); u.pn = (wgid % nig) / gsz; return true;
    }
};

template <class Epi, class Sched, bool ALIGN_EPI = true, bool SP2 = true>
__device__ __forceinline__ void gemm_phase(LAS unsigned char* lds, const Gemm g, const Sched& S, const Epi& E) {
    const int tid = threadIdx.x, wid = __builtin_amdgcn_readfirstlane(tid >> 6), lane = tid & 63, wr = wid >> 2, wc = wid & 3, fr = lane & 15, fq = lane >> 4;
    const int K = g.K, nt = K / BK;
    unsigned voffA[2], voffB[2];
#pragma unroll
    for (int i = 0; i < 2; ++i) { int R, C; stage_rc(tid * 16 + i * 8192, R, C); const int Rb = Epi::PERM ? ((R & ~31) + perm32(R & 31)) : R;
        voffA[i] = (unsigned)((long)R * g.lda + C) * 2u; voffB[i] = (unsigned)(Rb * K + C) * 2u; }
    const size_t kstepA = (size_t)g.akstep, kstepB = (size_t)(BK * 2);
    const size_t hstepA = (size_t)HALF * (size_t)g.lda * 2, hstepB = (size_t)HALF * K * 2;
    const size_t tstepB = 2 * hstepB;
    const unsigned ldsw = (unsigned)wid * 1024u;
    const int aoff = lds_byte(wr * 64 + fr, fq * 8), boff = lds_byte(wc * 32 + fr, fq * 8);
#define PG8_SA(b, h) (((b) * 2 + (h)) * HTB)
#define PG8_SB(b, h) ((4 + (b) * 2 + (h)) * HTB)
#define PG8_STAGE(bufoff, gbase, voff) do { _Pragma("unroll") for (int _i = 0; _i < 2; ++_i) \
        __builtin_amdgcn_global_load_lds((const unsigned*)((const char*)(gbase) + (voff)[_i]), (LAS unsigned*)(lds + (bufoff) + ldsw + _i * 8192), 16, 0, 0); } while (0)
#define PG8_LDA(dst, b, h) do { _Pragma("unroll") for (int m = 0; m < 4; ++m) _Pragma("unroll") for (int k = 0; k < 2; ++k) dst[m][k] = *(const LAS bf16x8*)(lds + PG8_SA(b, h) + aoff + m * 2048 + k * 1024); } while (0)
#define PG8_LDB(dst, b, h) do { _Pragma("unroll") for (int n = 0; n < 2; ++n) _Pragma("unroll") for (int k = 0; k < 2; ++k) dst[n][k] = *(const LAS bf16x8*)(lds + PG8_SB(b, h) + boff + n * 2048 + k * 1024); } while (0)
#define PG8_MMA(ai, bj, At, Bt) do { __builtin_amdgcn_s_setprio(1); _Pragma("unroll") for (int m = 0; m < 4; ++m) _Pragma("unroll") for (int n = 0; n < 2; ++n) _Pragma("unroll") for (int k = 0; k < 2; ++k) \
        acc[ai][bj][m][n] = __builtin_amdgcn_mfma_f32_16x16x32_bf16(Bt[n][k], At[m][k], acc[ai][bj][m][n], 0, 0, 0); __builtin_amdgcn_s_setprio(0); } while (0)
#define PG8_WAIT_V(n) asm volatile("s_waitcnt vmcnt(" #n ")" ::: "memory")
#define PG8_WAIT_L(n) asm volatile("s_waitcnt lgkmcnt(" #n ")" ::: "memory")
#define PG8_BAR __builtin_amdgcn_s_barrier()
#define PG8_SCHED __builtin_amdgcn_sched_barrier(0)
    Unit cur, nxt; int ui = 0;
    if (!S.next(0, cur)) return;
    f32x4 acc[2][2][4][2];
#pragma unroll
    for (int a = 0; a < 2; ++a)
#pragma unroll
        for (int b = 0; b < 2; ++b)
#pragma unroll
            for (int m = 0; m < 4; ++m)
#pragma unroll
                for (int n = 0; n < 2; ++n) acc[a][b][m][n] = (f32x4){0.f, 0.f, 0.f, 0.f};
    bf16x8 At[4][2], B0[2][2], B1[2][2];
    const char* cA = (const char*)g.A + a_unit_off(g, cur.pm); const char* cB = (const char*)g.Bt + (size_t)cur.pn * tstepB;
    if constexpr (SP2) {
        PG8_STAGE(PG8_SB(0, 0), cB, voffB); PG8_STAGE(PG8_SB(0, 1), cB + hstepB, voffB); PG8_STAGE(PG8_SA(0, 0), cA, voffA); PG8_STAGE(PG8_SA(0, 1), cA + hstepA, voffA);
        if (wr == 1) PG8_BAR;
        PG8_WAIT_V(2); PG8_BAR;
        PG8_STAGE(PG8_SB(1, 0), cB + kstepB, voffB); PG8_STAGE(PG8_SA(1, 0), cA + kstepA, voffA); PG8_STAGE(PG8_SB(1, 1), cB + hstepB + kstepB, voffB);
        PG8_WAIT_V(6); PG8_BAR;
    } else {
        PG8_STAGE(PG8_SB(0, 0), cB, voffB); PG8_STAGE(PG8_SA(0, 0), cA, voffA); PG8_STAGE(PG8_SB(0, 1), cB + hstepB, voffB); PG8_STAGE(PG8_SA(0, 1), cA + hstepA, voffA);
        if (wr == 1) PG8_BAR;
        PG8_WAIT_V(4); PG8_BAR;
        PG8_STAGE(PG8_SB(1, 0), cB + kstepB, voffB); PG8_STAGE(PG8_SA(1, 0), cA + kstepA, voffA); PG8_STAGE(PG8_SB(1, 1), cB + hstepB + kstepB, voffB);
        PG8_WAIT_V(6); PG8_BAR;
    }
    for (;;) {
        const bool has_next = S.next(ui + 1, nxt);
        const char* nA = has_next ? (const char*)g.A + a_unit_off(g, nxt.pm) : cA; const char* nB = has_next ? (const char*)g.Bt + (size_t)nxt.pn * tstepB : cB;
#pragma nounroll
        for (int t = 0; t < nt; t += 2) {
            const bool last = (t == nt - 2);
            const char* a1 = cA + (size_t)(t + 1) * kstepA;
            const char* a2 = last ? nA : cA + (size_t)(t + 2) * kstepA; const char* b2 = last ? nB : cB + (size_t)(t + 2) * kstepB;
            const char* a3 = a2 + kstepA; const char* b3 = b2 + kstepB;
            if constexpr (SP2) {
            PG8_LDB(B0, 0, 0); PG8_LDB(B1, 0, 1); PG8_SCHED; PG8_LDA(At, 0, 0); PG8_STAGE(PG8_SA(1, 1), a1 + hstepA, voffA);
            PG8_WAIT_V(8); PG8_WAIT_L(0); PG8_BAR; PG8_MMA(0, 0, At, B0); PG8_MMA(0, 1, At, B1); PG8_BAR; PG8_SCHED;
            PG8_LDA(At, 0, 1); PG8_STAGE(PG8_SB(0, 0), b2, voffB); PG8_STAGE(PG8_SB(0, 1), b2 + hstepB, voffB); PG8_STAGE(PG8_SA(0, 0), a2, voffA);
            PG8_WAIT_V(8); PG8_WAIT_L(0); PG8_BAR; PG8_MMA(1, 0, At, B0); PG8_MMA(1, 1, At, B1); PG8_BAR; PG8_SCHED;
            PG8_LDB(B0, 1, 0); PG8_LDB(B1, 1, 1); PG8_SCHED; PG8_LDA(At, 1, 0); PG8_STAGE(PG8_SA(0, 1), a2 + hstepA, voffA);
            PG8_WAIT_V(8); PG8_WAIT_L(0); PG8_BAR; PG8_MMA(0, 0, At, B0); PG8_MMA(0, 1, At, B1); PG8_BAR; PG8_SCHED;
            PG8_LDA(At, 1, 1); PG8_STAGE(PG8_SB(1, 0), b3, voffB); PG8_STAGE(PG8_SB(1, 1), b3 + hstepB, voffB); PG8_STAGE(PG8_SA(1, 0), a3, voffA);
            PG8_WAIT_V(8); PG8_WAIT_L(0); PG8_BAR; PG8_MMA(1, 0, At, B0); PG8_MMA(1, 1, At, B1); PG8_BAR; PG8_SCHED;
            } else {
            PG8_LDB(B0, 0, 0); PG8_SCHED; PG8_LDA(At, 0, 0); PG8_STAGE(PG8_SA(1, 1), a1 + hstepA, voffA);
            PG8_WAIT_L(8); PG8_BAR; PG8_WAIT_L(0); PG8_MMA(0, 0, At, B0); PG8_BAR; PG8_SCHED;
            PG8_LDB(B1, 0, 1); PG8_STAGE(PG8_SB(0, 0), b2, voffB);
            PG8_BAR; PG8_WAIT_L(0); PG8_MMA(0, 1, At, B1); PG8_BAR;
            PG8_LDA(At, 0, 1); PG8_STAGE(PG8_SA(0, 0), a2, voffA);
            PG8_BAR; PG8_WAIT_L(0); PG8_MMA(1, 0, At, B0); PG8_BAR; PG8_SCHED;
            PG8_STAGE(PG8_SB(0, 1), b2 + hstepB, voffB);
            PG8_WAIT_V(6); PG8_BAR; PG8_MMA(1, 1, At, B1); PG8_BAR;
            PG8_LDB(B0, 1, 0); PG8_SCHED; PG8_LDA(At, 1, 0); PG8_STAGE(PG8_SA(0, 1), a2 + hstepA, voffA);
            PG8_WAIT_L(8); PG8_BAR; PG8_WAIT_L(0); PG8_MMA(0, 0, At, B0); PG8_BAR; PG8_SCHED;
            PG8_LDB(B1, 1, 1); PG8_STAGE(PG8_SB(1, 0), b3, voffB);
            PG8_BAR; PG8_WAIT_L(0); PG8_MMA(0, 1, At, B1); PG8_BAR;
            PG8_LDA(At, 1, 1); PG8_STAGE(PG8_SA(1, 0), a3, voffA);
            PG8_BAR; PG8_WAIT_L(0); PG8_MMA(1, 0, At, B0); PG8_BAR; PG8_SCHED;
            PG8_STAGE(PG8_SB(1, 1), b3 + hstepB, voffB);
            PG8_WAIT_V(6); PG8_BAR; PG8_MMA(1, 1, At, B1); PG8_BAR;
            }
        }
        if constexpr (ALIGN_EPI) { if (wr == 0) PG8_BAR; }
        E(acc, cur, wr, wc, fr, fq);
        if (!has_next) break;
#pragma unroll
        for (int a = 0; a < 2; ++a)
#pragma unroll
            for (int b = 0; b < 2; ++b)
#pragma unroll
                for (int m = 0; m < 4; ++m)
#pragma unroll
                    for (int n = 0; n < 2; ++n) acc[a][b][m][n] = (f32x4){0.f, 0.f, 0.f, 0.f};
        cur = nxt; cA = nA; cB = nB; ++ui;
        if constexpr (ALIGN_EPI) { if (wr == 1) PG8_BAR; }
    }
    PG8_WAIT_V(0);
    if constexpr (!ALIGN_EPI) { if (wr == 0) PG8_BAR; }
    PG8_BAR;
#undef PG8_SA
#undef PG8_SB
#undef PG8_STAGE
#undef PG8_LDA
#undef PG8_LDB
#undef PG8_MMA
#undef PG8_WAIT_V
#undef PG8_WAIT_L
#undef PG8_BAR
#undef PG8_SCHED
}
}

template <int MODE> struct Epi {
    static constexpr bool PERM = true;
    bf16_t* O; int ldc; const float* rowscale; const float* bias; float* psq; bf16_t* OT; float* outf; const bf16_t* pe;
    __device__ __forceinline__ void operator()(const f32x4 (&acc)[2][2][4][2], const pg8::Unit& u, int wr, int wc, int fr, int fq) const {
#pragma unroll
        for (int ai = 0; ai < 2; ++ai)
#pragma unroll
            for (int m = 0; m < 4; ++m) {
                const int r = u.pm * 256 + ai * 128 + wr * 64 + m * 16 + fr;
                float rs = 1.f;
                if (MODE == 0 || MODE == 5) rs = rowscale[r];
                float ssq = 0.f;
#pragma unroll
                for (int bj = 0; bj < 2; ++bj) {
                    const int c0 = u.pn * 256 + bj * 128 + wc * 32 + 8 * fq;
                    const f32x4 a0 = acc[ai][bj][m][0], a1 = acc[ai][bj][m][1];
                    float v[8] = {a0[0], a0[1], a0[2], a0[3], a1[0], a1[1], a1[2], a1[3]};
                    if (MODE == 0) {
#pragma unroll
                        for (int j = 0; j < 8; ++j) v[j] *= rs;
                        if (u.pn == 4) {
                            const int b = r >> 12, t = r & 4095, cc = wc * 32 + 8 * fq;
                            bf16_t* vt = OT + (size_t)bj * ((size_t)16 * 128 * 4096) + ((size_t)(b * 128 + cc)) * 4096 + t;
#pragma unroll
                            for (int j = 0; j < 8; ++j) vt[(size_t)j * 4096] = f2bf(v[j]);
                        } else {
                            *(u32x4*)(O + (size_t)r * ldc + c0) = pack8(v);
                        }
                    } else if (MODE == 1) {
                        const f32x4 b0 = *(const f32x4*)(bias + c0), b1 = *(const f32x4*)(bias + c0 + 4);
                        const float bb[8] = {b0[0], b0[1], b0[2], b0[3], b1[0], b1[1], b1[2], b1[3]};
#pragma unroll
                        for (int j = 0; j < 8; ++j) { const float x = v[j] + bb[j]; const float uu = 0.7978845608028654f * (x + 0.044715f * x * x * x); v[j] = x * sigm(2.f * uu); }
                        *(u32x4*)(O + (size_t)r * ldc + c0) = pack8(v);
                    } else if (MODE == 2) {
                        *(u32x4*)(O + (size_t)r * ldc + c0) = pack8(v);
                    } else if (MODE == 3) {
                        if (u.pn == 0 && c0 < 64) {
                            const int bg = r >> 8, n = r & 255;
#pragma unroll
                            for (int j = 0; j < 8; ++j) OT[((size_t)(bg * 64 + c0 + j)) * 256 + n] = f2bf(v[j]);
                        }
                    } else if (MODE == 4) {
#pragma unroll
                        for (int j = 0; j < 8; ++j) ssq += v[j] * v[j];
                        *(u32x4*)(O + (size_t)r * ldc + c0) = pack8(v);
                    } else if (MODE == 5) {
#pragma unroll
                        for (int j = 0; j < 8; ++j) { const float x = fmaxf(v[j] * rs, 0.f); v[j] = x * x; }
                        __builtin_nontemporal_store(pack8(v), (u32x4*)(O + (size_t)r * ldc + c0));
                    } else if (MODE == 6) {
                        float* op = outf + (size_t)r * DM + c0;
                        const u32x4 xw = *(const u32x4*)(O + (size_t)r * DM + c0);
                        float xf[8]; unpack8(xw, xf);
                        const u32x4 pw = *(const u32x4*)(pe + (size_t)r * DM + c0);
                        float pf[8]; unpack8(pw, pf);
                        f32x4 o0, o1;
#pragma unroll
                        for (int j = 0; j < 4; ++j) { o0[j] = xf[j] + sigm(v[j]) * pf[j]; o1[j] = xf[4 + j] + sigm(v[4 + j]) * pf[4 + j]; }
                        *(f32x4*)op = o0; *(f32x4*)(op + 4) = o1;
                    }
                }
                if (MODE == 4) {
                    ssq += __shfl_xor(ssq, 16); ssq += __shfl_xor(ssq, 32);
                    if (fq == 0) psq[(size_t)r * 16 + u.pn * 4 + wc] = ssq;
                }
                asm volatile("" ::: "memory");
            }
    }
};

template <int MODE>
__device__ __forceinline__ void run_gemm(LAS unsigned char* lds, const bf16_t* A, const bf16_t* Bt, int M, int N, int K, long lda, long akstep, int amode, int c, const Epi<MODE>& E) {
    pg8::Gemm g{A, Bt, M, N, K, lda, akstep, amode};
    pg8::StaticOrder S; S.init(M, N, (int)gridDim.x, c);
    pg8::gemm_phase<Epi<MODE>, pg8::StaticOrder, true, true>(lds, g, S, E);
}

__device__ __forceinline__ void tr_matrix(const float* W, int K, int ldn, int c0src, int ncols, bf16_t* WT, int ldk, int dst_row0, int dst_k0,
                                          const float* rsc, float cs, LAS float* scr, int gw, int NGW, int lane) {
    const int nkb = K / 64, nnb = (ncols + 31) / 32, nit = nkb * nnb;
    for (int it = gw; it < nit; it += NGW) {
        const int kb = it / nnb, nb = it % nnb, k0 = kb * 64, n0 = nb * 32, ncv = (ncols - n0) < 32 ? (ncols - n0) : 32;
#pragma unroll 8
        for (int i = 0; i < 32; ++i) { const int kk = 2 * i + (lane >> 5), col = lane & 31;
            float val = 0.f;
            if (col < ncv) { val = W[(size_t)(k0 + kk) * ldn + c0src + n0 + col]; if (rsc) val *= rsc[k0 + kk]; val *= cs; }
            scr[kk * 33 + col] = val; }
        LDS_WAIT(); asm volatile("" ::: "memory");
        const int c = lane & 7;
#pragma unroll
        for (int j = 0; j < 4; ++j) { const int n = (lane >> 3) + 8 * j; const LAS float* s = scr + (8 * c) * 33 + n;
            if (n < ncv) {
                u32x4 o; o.x = pk2(s[0 * 33], s[1 * 33]); o.y = pk2(s[2 * 33], s[3 * 33]); o.z = pk2(s[4 * 33], s[5 * 33]); o.w = pk2(s[6 * 33], s[7 * 33]);
                *(u32x4*)(WT + (size_t)(dst_row0 + n0 + n) * ldk + dst_k0 + k0 + 8 * c) = o; } }
        LDS_WAIT(); asm volatile("" ::: "memory");
    }
}

template <int CTRL> __device__ __forceinline__ float dppf(float x) { return __int_as_float(__builtin_amdgcn_update_dpp(0, __float_as_int(x), CTRL, 0xF, 0xF, false)); }
__device__ __forceinline__ float allred16(float x) { x += dppf<0xB1>(x); x += dppf<0x4E>(x); x += dppf<0x141>(x); x += dppf<0x140>(x); return x; }

#define MFMA16K16(a, b, c) __builtin_amdgcn_mfma_f32_16x16x16bf16_1k(a, b, c, 0, 0, 0)
#define MFMA16x32(a, b, c) __builtin_amdgcn_mfma_f32_16x16x32_bf16(a, b, c, 0, 0, 0)
constexpr int S2_CHB = 12544, S2_APT = 0, S2_RT = 2304, S2_WT = 4608, S2_BRT = 5120, S2_KRT = 5632, S2_B2T = 6144, S2_K2T = 8192, S2_VT = 10240, S2_GC = 12288;
constexpr int S2_PS = 2 * 4 * S2_CHB, S2_PSB = 8960, S2_AT = 0, S2_BT = 2304, S2_KT = 4608, S2_ATT = 6912;
constexpr int S2_N = 0, S2_NT = 512, S2_N2 = 1024, S2_N2T = 1536, S2_N4 = 2048, S2_N4T = 2560, S2_N8T = 3072, S2_P = 3584, S2_AAK = 4096, S2_TT = 4608;
constexpr int S2_CS = S2_PS + 4 * S2_PSB, S2_CSB = 2816, S2_SB = 0, S2_SG = 2304;
static_assert(S2_CS + 4 * S2_CSB <= LDS_BYTES, "scan LDS map");

__device__ __forceinline__ f32x4 mm64(const LAS unsigned char* A, const LAS unsigned char* B, f32x4 c, int l15, int g4) {
    const bf16x8 a0 = *(const LAS bf16x8*)(A + l15 * 144 + g4 * 16), a1 = *(const LAS bf16x8*)(A + l15 * 144 + g4 * 16 + 64);
    const bf16x8 b0 = *(const LAS bf16x8*)(B + l15 * 144 + g4 * 16), b1 = *(const LAS bf16x8*)(B + l15 * 144 + g4 * 16 + 64);
    c = MFMA16x32(a0, b0, c); c = MFMA16x32(a1, b1, c); return c; }
__device__ __forceinline__ f32x4 mm16(const LAS unsigned char* A, const LAS unsigned char* B, f32x4 c, int l15, int g4) {
    const s16x4 a = *(const LAS s16x4*)(A + l15 * 32 + g4 * 8), b = *(const LAS s16x4*)(B + l15 * 32 + g4 * 8);
    return MFMA16K16(a, b, c); }
__device__ __forceinline__ void st_T(LAS unsigned char* base, int row_bytes, f32x4 d, int l15, int g4) {
    u32x2 w; w.x = pk2(d[0], d[1]); w.y = pk2(d[2], d[3]); *(LAS u32x2*)(base + l15 * row_bytes + g4 * 8) = w; }
__device__ __forceinline__ void st_RM(LAS unsigned char* base, f32x4 d, int l15, int g4) {
#pragma unroll
    for (int i = 0; i < 4; ++i) *(LAS bf16_t*)(base + (4 * g4 + i) * 32 + l15 * 2) = f2bf(d[i]); }
__device__ __forceinline__ float wsum64(float x) {
    x = allred16(x);
    const float t0 = __int_as_float(__builtin_amdgcn_readlane(__float_as_int(x), 0)), t1 = __int_as_float(__builtin_amdgcn_readlane(__float_as_int(x), 16));
    const float t2 = __int_as_float(__builtin_amdgcn_readlane(__float_as_int(x), 32)), t3 = __int_as_float(__builtin_amdgcn_readlane(__float_as_int(x), 48));
    return (t0 + t1) + (t2 + t3); }

__device__ __forceinline__ void s2_load(const bf16_t* z, const bf16_t* lo, int b, int hc, int tok0, unsigned (&rw)[16][5], unsigned (&pv3)[3]) {
    const size_t row0 = (size_t)b * SEQ + tok0;
    pv3[0] = 0u; pv3[1] = 0u; pv3[2] = 0u;
    if (tok0 > 0) { const bf16_t* zp = z + (row0 - 1) * ZLD; pv3[0] = zp[ZR + hc]; pv3[1] = zp[ZK + hc]; pv3[2] = zp[ZV + hc]; }
#pragma unroll
    for (int t = 0; t < 16; ++t) {
        const bf16_t* zr = z + (row0 + t) * ZLD;
        rw[t][0] = zr[ZR + hc]; rw[t][1] = zr[ZK + hc]; rw[t][2] = zr[ZV + hc];
        rw[t][3] = lo[(row0 + t) * 1536 + hc]; rw[t][4] = lo[(row0 + t) * 1536 + 512 + hc];
    }
}
__device__ __forceinline__ void s2_produce(LAS unsigned char* CB, LAS unsigned char* PSb, LAS unsigned char* APTp, const unsigned (&rw)[16][5], const unsigned (&pv3)[3], int lane,
        float mur, float muk, float muv, float w0v, float a0v, float kkv, float kav) {
    const int l15 = lane & 15, g4 = lane >> 4;
    asm volatile("" ::: "memory");
    float pr = __uint_as_float(pv3[0] << 16), pk = __uint_as_float(pv3[1] << 16), pv = __uint_as_float(pv3[2] << 16);
    float btv[16], ktv[16]; unsigned atp[8], vtp[8];
    float Lam = 0.f, eP = 1.f, hold_a = 0.f, hold_v = 0.f;
#pragma unroll
    for (int t = 0; t < 16; ++t) {
        const float cr = __uint_as_float(rw[t][0] << 16), ck = __uint_as_float(rw[t][1] << 16), cv = __uint_as_float(rw[t][2] << 16);
        const float lw = __uint_as_float(rw[t][3] << 16), la = __uint_as_float(rw[t][4] << 16);
        const float r = cr + (pr - cr) * mur, k = ck + (pk - ck) * muk, v = cv + (pv - cv) * muv;
        pr = cr; pk = ck; pv = cv;
        const float aic = sigm(a0v + la);
        const float lam = -0.6065306597126334f * __builtin_amdgcn_rcpf(1.f + __expf(-(w0v + lw)));
        const float kk = k * kkv; const float ss = wsum64(kk * kk);
        const float kn = kk * rsqrtf(fmaxf(ss, 1e-24f));
        const float k2 = k * (1.f + (aic - 1.f) * kav);
        Lam += lam;
        const float eL = __expf(Lam), eLm = __builtin_amdgcn_rcpf(eL);
        const float at = -kn * eP, rt = r * eL, bt = kn * aic * eLm, kt = k2 * eLm;
        eP = eL;
        *(LAS bf16_t*)(PSb + S2_AT + t * 144 + lane * 2) = f2bf(at);
        *(LAS bf16_t*)(PSb + S2_BT + t * 144 + lane * 2) = f2bf(bt);
        *(LAS bf16_t*)(PSb + S2_KT + t * 144 + lane * 2) = f2bf(kt);
        *(LAS bf16_t*)(CB + S2_RT + t * 144 + lane * 2) = f2bf(rt);
        btv[t] = bt; ktv[t] = kt;
        if (t & 1) { atp[t >> 1] = pk2(hold_a, at); vtp[t >> 1] = pk2(hold_v, v); } else { hold_a = at; hold_v = v; }
    }
    const float gC = eP;
    *(LAS float*)(CB + S2_GC + lane * 4) = gC;
    { u32x4 w0 = {atp[0], atp[1], atp[2], atp[3]}, w1 = {atp[4], atp[5], atp[6], atp[7]};
      *(LAS u32x4*)(PSb + S2_ATT + lane * 32) = w0; *(LAS u32x4*)(PSb + S2_ATT + lane * 32 + 16) = w1;
      u32x4 v0 = {vtp[0], vtp[1], vtp[2], vtp[3]}, v1 = {vtp[4], vtp[5], vtp[6], vtp[7]};
      *(LAS u32x4*)(CB + S2_VT + lane * 32) = v0; *(LAS u32x4*)(CB + S2_VT + lane * 32 + 16) = v1;
      u32x4 b0, b1, k0, k1;
      b0.x = pk2(btv[0] * gC, btv[1] * gC); b0.y = pk2(btv[2] * gC, btv[3] * gC); b0.z = pk2(btv[4] * gC, btv[5] * gC); b0.w = pk2(btv[6] * gC, btv[7] * gC);
      b1.x = pk2(btv[8] * gC, btv[9] * gC); b1.y = pk2(btv[10] * gC, btv[11] * gC); b1.z = pk2(btv[12] * gC, btv[13] * gC); b1.w = pk2(btv[14] * gC, btv[15] * gC);
      k0.x = pk2(ktv[0] * gC, ktv[1] * gC); k0.y = pk2(ktv[2] * gC, ktv[3] * gC); k0.z = pk2(ktv[4] * gC, ktv[5] * gC); k0.w = pk2(ktv[6] * gC, ktv[7] * gC);
      k1.x = pk2(ktv[8] * gC, ktv[9] * gC); k1.y = pk2(ktv[10] * gC, ktv[11] * gC); k1.z = pk2(ktv[12] * gC, ktv[13] * gC); k1.w = pk2(ktv[14] * gC, ktv[15] * gC);
      *(LAS u32x4*)(CB + S2_B2T + lane * 32) = b0; *(LAS u32x4*)(CB + S2_B2T + lane * 32 + 16) = b1;
      *(LAS u32x4*)(CB + S2_K2T + lane * 32) = k0; *(LAS u32x4*)(CB + S2_K2T + lane * 32 + 16) = k1; }
    asm volatile("" ::: "memory");
    const f32x4 z4 = {0.f, 0.f, 0.f, 0.f};
    f32x4 dN = mm64(PSb + S2_BT, PSb + S2_AT, z4, l15, g4);
    f32x4 dAak = mm64(PSb + S2_KT, PSb + S2_AT, z4, l15, g4);
    f32x4 dBr = mm64(PSb + S2_BT, CB + S2_RT, z4, l15, g4);
    f32x4 dKr = mm64(PSb + S2_KT, CB + S2_RT, z4, l15, g4);
    f32x4 P;
#pragma unroll
    for (int i = 0; i < 4; ++i) { const int sidx = 4 * g4 + i;
        dN[i] = (sidx < l15) ? dN[i] : 0.f; dAak[i] = (sidx < l15) ? dAak[i] : 0.f;
        dBr[i] = (sidx <= l15) ? dBr[i] : 0.f; dKr[i] = (sidx <= l15) ? dKr[i] : 0.f;
        P[i] = dN[i] + ((sidx == l15) ? 1.f : 0.f); }
    asm volatile("s_waitcnt lgkmcnt(0)" ::: "memory");
    st_RM(PSb + S2_N, dN, l15, g4); st_T(PSb + S2_NT, 32, dN, l15, g4); st_RM(PSb + S2_AAK, dAak, l15, g4);
    st_T(CB + S2_BRT, 32, dBr, l15, g4); st_T(CB + S2_KRT, 32, dKr, l15, g4);
    st_RM(PSb + S2_P, P, l15, g4);
    asm volatile("" ::: "memory");
    const f32x4 n2 = mm16(PSb + S2_N, PSb + S2_NT, z4, l15, g4);
    asm volatile("" ::: "memory");
    st_RM(PSb + S2_N2, n2, l15, g4); st_T(PSb + S2_N2T, 32, n2, l15, g4);
    asm volatile("" ::: "memory");
    P = mm16(PSb + S2_P, PSb + S2_N2T, P, l15, g4);
    asm volatile("s_waitcnt lgkmcnt(0)" ::: "memory");
    st_RM(PSb + S2_P, P, l15, g4);
    asm volatile("" ::: "memory");
    const f32x4 n4 = mm16(PSb + S2_N2, PSb + S2_N2T, z4, l15, g4);
    asm volatile("" ::: "memory");
    st_RM(PSb + S2_N4, n4, l15, g4); st_T(PSb + S2_N4T, 32, n4, l15, g4);
    asm volatile("" ::: "memory");
    P = mm16(PSb + S2_P, PSb + S2_N4T, P, l15, g4);
    asm volatile("s_waitcnt lgkmcnt(0)" ::: "memory");
    st_RM(PSb + S2_P, P, l15, g4);
    asm volatile("" ::: "memory");
    const f32x4 n8 = mm16(PSb + S2_N4, PSb + S2_N4T, z4, l15, g4);
    asm volatile("" ::: "memory");
    st_T(PSb + S2_N8T, 32, n8, l15, g4);
    asm volatile("" ::: "memory");
    const f32x4 Tm = mm16(PSb + S2_P, PSb + S2_N8T, P, l15, g4);
    asm volatile("" ::: "memory");
    st_T(PSb + S2_TT, 32, Tm, l15, g4);
    asm volatile("" ::: "memory");
    const f32x4 W = mm16(PSb + S2_AAK, PSb + S2_TT, z4, l15, g4);
    asm volatile("" ::: "memory");
    st_T(CB + S2_WT, 32, W, l15, g4);
#pragma unroll
    for (int kt = 0; kt < 4; ++kt) {
        const f32x4 ap = mm16(PSb + S2_ATT + kt * 512, PSb + S2_TT, z4, l15, g4);
        st_T(APTp + kt * 32, 144, ap, l15, g4);
    }
}

__device__ __forceinline__ unsigned char* s2_block(unsigned char* ws, float* out, int c) {
    if (c < 10699) return ws + WS_RC + (size_t)c * S2_CHB;
    c -= 10699; if (c < 8024) return ws + WS_RA + (size_t)416 * MiB + (size_t)c * S2_CHB;
    c -= 8024; if (c < 5349) return (unsigned char*)out + (size_t)192 * MiB + (size_t)c * S2_CHB;
    c -= 5349; if (c < 2674) return ws + WS_LORAA + (size_t)c * S2_CHB;
    c -= 2674; return ws + WS_END + (size_t)c * S2_CHB;
}
__device__ __forceinline__ void scan_precompute(LAS unsigned char* lds, const Args& a, const bf16_t* z, const bf16_t* lo) {
    const int tid = threadIdx.x, lane = tid & 63, wid = __builtin_amdgcn_readfirstlane(tid >> 6);
    LAS unsigned char* WB = lds + wid * (S2_CHB - 2304 + S2_PSB);
    LAS unsigned char* CB = WB - 2304; LAS unsigned char* PSb = WB + (S2_CHB - 2304);
    const int nw = (int)gridDim.x * 8;
    unsigned rwA[16][5], pvA[3];
    { const int c = (int)blockIdx.x * 8 + wid; if (c < 32768) s2_load(z, lo, c >> 11, ((c >> 8) & 7) * 64 + lane, (c & 255) * 16, rwA, pvA); }
    const bool fixed_h = (nw & 2047) == 0;
    int hc = ((((int)blockIdx.x * 8 + wid) >> 8) & 7) * 64 + lane;
    float mur = a.in[16][hc], muk = a.in[16][512 + hc], muv = a.in[16][1024 + hc], w0v = a.in[17][hc], a0v = a.in[19][hc], kkv = a.in[22][hc], kav = a.in[23][hc];
    for (int c = (int)blockIdx.x * 8 + wid; c < 32768; c += nw) {
        if (!fixed_h) { hc = ((c >> 8) & 7) * 64 + lane;
            mur = a.in[16][hc]; muk = a.in[16][512 + hc]; muv = a.in[16][1024 + hc]; w0v = a.in[17][hc]; a0v = a.in[19][hc]; kkv = a.in[22][hc]; kav = a.in[23][hc]; }
        unsigned rwB[16][5], pvB[3];
        { const int cn = c + nw; if (cn < 32768) s2_load(z, lo, cn >> 11, ((cn >> 8) & 7) * 64 + lane, (cn & 255) * 16, rwB, pvB); }
        s2_produce(CB, PSb, PSb, rwA, pvA, lane, mur, muk, muv, w0v, a0v, kkv, kav);
#pragma unroll
        for (int t = 0; t < 16; ++t)
#pragma unroll
            for (int q = 0; q < 5; ++q) rwA[t][q] = rwB[t][q];
        pvA[0] = pvB[0]; pvA[1] = pvB[1]; pvA[2] = pvB[2];
        asm volatile("s_waitcnt lgkmcnt(0)" ::: "memory");
        u32x4* dst = (u32x4*)s2_block(a.ws, a.out, c);
#pragma unroll
        for (int k = 0; k < 3; ++k) { const int idx = lane + 64 * k; if (idx < 144) dst[idx] = *(const LAS u32x4*)(PSb + idx * 16); }
#pragma unroll
        for (int k = 0; k < 10; ++k) { const int idx = lane + 64 * k; dst[144 + idx] = *(const LAS u32x4*)(WB + idx * 16); }
        asm volatile("s_waitcnt lgkmcnt(0)" ::: "memory");
    }
}
__device__ __forceinline__ void scan_phase(LAS unsigned char* lds, const Args& a, const bf16_t* z, const bf16_t* lo, float* yraw) {
    const int tid = threadIdx.x, lane = tid & 63, wid = __builtin_amdgcn_readfirstlane(tid >> 6);
    const int l15 = lane & 15, g4 = lane >> 4;
    constexpr int NIT = SEQ / 64;
    for (int unit = blockIdx.x; unit < 128; unit += gridDim.x) {
        const int b = unit >> 3, h = unit & 7;
        __syncthreads();
        if (wid >= 4) {
            const int pw = wid - 4, c0 = unit * 256;
            { const u32x4* src = (const u32x4*)s2_block(a.ws, a.out, c0 + pw); LAS unsigned char* dstl = lds + (0 * 4 + pw) * S2_CHB;
              u32x4 tmp[13];
#pragma unroll
              for (int k = 0; k < 13; ++k) { const int idx = lane + 64 * k; if (idx < S2_CHB / 16) tmp[k] = src[idx]; }
#pragma unroll
              for (int k = 0; k < 13; ++k) { const int idx = lane + 64 * k; if (idx < S2_CHB / 16) *(LAS u32x4*)(dstl + idx * 16) = tmp[k]; } }
            __syncthreads();
            for (int it = 0; it < NIT; ++it) {
                if (it + 1 < NIT) { const u32x4* src = (const u32x4*)s2_block(a.ws, a.out, c0 + (it + 1) * 4 + pw); LAS unsigned char* dstl = lds + (((it + 1) & 1) * 4 + pw) * S2_CHB;
                  u32x4 tmp[13];
#pragma unroll
                  for (int k = 0; k < 13; ++k) { const int idx = lane + 64 * k; if (idx < S2_CHB / 16) tmp[k] = src[idx]; }
#pragma unroll
                  for (int k = 0; k < 13; ++k) { const int idx = lane + 64 * k; if (idx < S2_CHB / 16) *(LAS u32x4*)(dstl + idx * 16) = tmp[k]; } }
                __syncthreads();
            }
        } else {
            const int vt = wid;
            LAS unsigned char* SB = lds + S2_CS + vt * S2_CSB + S2_SB; LAS unsigned char* SG = lds + S2_CS + vt * S2_CSB + S2_SG;
            f32x4 St[4];
#pragma unroll
            for (int kt = 0; kt < 4; ++kt) St[kt] = (f32x4){0.f, 0.f, 0.f, 0.f};
            __syncthreads();
            for (int it = 0; it < NIT; ++it) {
                for (int j = 0; j < 4; ++j) {
                    const LAS unsigned char* CB = lds + ((it & 1) * 4 + j) * S2_CHB;
                    asm volatile("" ::: "memory");
                    s16x4 sbf[4];
#pragma unroll
                    for (int kt = 0; kt < 4; ++kt) { u32x2 w; w.x = pk2(St[kt][0], St[kt][1]); w.y = pk2(St[kt][2], St[kt][3]); sbf[kt] = __builtin_bit_cast(s16x4, w); }
                    const s16x4 vtf = *(const LAS s16x4*)(CB + S2_VT + (vt * 16 + l15) * 32 + g4 * 8);
                    f32x4 sg = {0.f, 0.f, 0.f, 0.f};
                    { const s16x4 wf = *(const LAS s16x4*)(CB + S2_WT + l15 * 32 + g4 * 8);
                      sg = MFMA16K16(wf, vtf, sg);
#pragma unroll
                      for (int kt = 0; kt < 4; ++kt) { const s16x4 af = *(const LAS s16x4*)(CB + S2_APT + l15 * 144 + kt * 32 + g4 * 8); sg = MFMA16K16(af, sbf[kt], sg); } }
                    s16x4 sgf; { u32x2 w; w.x = pk2(sg[0], sg[1]); w.y = pk2(sg[2], sg[3]); sgf = __builtin_bit_cast(s16x4, w); }
                    f32x4 yy = {0.f, 0.f, 0.f, 0.f};
                    { const s16x4 brf = *(const LAS s16x4*)(CB + S2_BRT + l15 * 32 + g4 * 8), krf = *(const LAS s16x4*)(CB + S2_KRT + l15 * 32 + g4 * 8);
                      yy = MFMA16K16(krf, vtf, yy);
#pragma unroll
                      for (int kt = 0; kt < 4; ++kt) { const s16x4 rf = *(const LAS s16x4*)(CB + S2_RT + l15 * 144 + kt * 32 + g4 * 8); yy = MFMA16K16(rf, sbf[kt], yy); }
                      yy = MFMA16K16(brf, sgf, yy); }
                    { bf16_t* yp = (bf16_t*)yraw + ((size_t)b * SEQ + it * 64 + j * 16 + 4 * g4) * 512 + h * 64 + vt * 16 + l15;
#pragma unroll
                      for (int i = 0; i < 4; ++i) yp[(size_t)i * 512] = f2bf(yy[i]); }
#pragma unroll
                    for (int kt = 0; kt < 4; ++kt) {
                        const f32x4 gc = *(const LAS f32x4*)(CB + S2_GC + (16 * kt + 4 * g4) * 4);
                        const s16x4 b2f = *(const LAS s16x4*)(CB + S2_B2T + (16 * kt + l15) * 32 + g4 * 8), k2f = *(const LAS s16x4*)(CB + S2_K2T + (16 * kt + l15) * 32 + g4 * 8);
                        f32x4 sn = St[kt] * gc;
                        sn = MFMA16K16(k2f, vtf, sn); sn = MFMA16K16(b2f, sgf, sn);
                        St[kt] = sn;
                    }
                }
                __syncthreads();
            }
        }
    }
}

constexpr int NS_KCL = 0, NS_VCL = 36864, NS_IMP = 70656, NS_SELM = 137216, NS_UNI = 137728;
constexpr int NS_KT = NS_IMP, NS_VT = NS_IMP + 9216;

#define MFMA16(a, b, c) __builtin_amdgcn_mfma_f32_16x16x32_bf16(a, b, c, 0, 0, 0)

template <int MODE>
__device__ __forceinline__ void flash_tile(const LAS unsigned char* lds, unsigned kt_off, unsigned vt_off, const bf16x8 (&Qf)[2][2], f32x4 (&O)[4][2],
        float (&mrun)[2], float (&lrun)[2], float slope, const int (&tq)[2], int key0, const bool (&selb)[2], int l15, int g4, bool full) {
    asm volatile("" : "+v"(kt_off), "+v"(vt_off));
    const LAS unsigned char* KT = lds + kt_off; const LAS unsigned char* VT = lds + vt_off;
    f32x4 sc[4][2];
    float cb[2];
#pragma unroll
    for (int qs = 0; qs < 2; ++qs) cb[qs] = slope * (float)(key0 + 4 * g4 - tq[qs]) + ((MODE == 1 && !selb[qs]) ? -1e30f : 0.f);
    __builtin_amdgcn_s_setprio(1);
#pragma unroll
    for (int s = 0; s < 4; ++s) {
        const LAS unsigned char* kp = KT + (s * 16) * 144;
        const bf16x8 k0 = *(const LAS bf16x8*)kp, k1 = *(const LAS bf16x8*)(kp + 64);
#pragma unroll
        for (int qs = 0; qs < 2; ++qs) {
            f32x4 zz;
#pragma unroll
            for (int i = 0; i < 4; ++i) zz[i] = fmaf(slope, (float)(s * 16 + i), cb[qs]);
            zz = MFMA16(k0, Qf[qs][0], zz);
            sc[s][qs] = MFMA16(k1, Qf[qs][1], zz);
        }
        __builtin_amdgcn_sched_barrier(0);
    }
    __builtin_amdgcn_s_setprio(0);
    if (!full) {
#pragma unroll
        for (int qs = 0; qs < 2; ++qs)
#pragma unroll
            for (int s = 0; s < 4; ++s)
#pragma unroll
                for (int i = 0; i < 4; ++i) {
                    const int dist = (tq[qs] - key0 - 4 * g4) - (s * 16 + i);
                    const bool ok = (MODE == 1) ? (dist >= 0) : (dist >= 0 && dist < 512);
                    sc[s][qs][i] = ok ? sc[s][qs][i] : -1e30f;
                }
    }
#pragma unroll
    for (int qs = 0; qs < 2; ++qs) {
        float mx = -1e30f;
#pragma unroll
        for (int s = 0; s < 4; ++s)
#pragma unroll
            for (int i = 0; i < 4; ++i) mx = fmaxf(mx, sc[s][qs][i]);
        mx = fmaxf(mx, __shfl_xor(mx, 16)); mx = fmaxf(mx, __shfl_xor(mx, 32));
        const float mn = fmaxf(mrun[qs], mx);
        const float alpha = __builtin_amdgcn_exp2f(mrun[qs] - mn);
        mrun[qs] = mn;
        const float mnx = fmaxf(mn, -1e29f);
        float ps = 0.f;
#pragma unroll
        for (int s = 0; s < 4; ++s)
#pragma unroll
            for (int i = 0; i < 4; ++i) { const float p = __builtin_amdgcn_exp2f(sc[s][qs][i] - mnx); sc[s][qs][i] = p; ps += p; }
        lrun[qs] = lrun[qs] * alpha + ps;
#pragma unroll
        for (int d = 0; d < 4; ++d) O[d][qs] = O[d][qs] * alpha;
    }
    __builtin_amdgcn_s_setprio(1);
#pragma unroll
    for (int kk = 0; kk < 2; ++kk) {
        bf16x8 Pf[2];
#pragma unroll
        for (int qs = 0; qs < 2; ++qs) { u32x4 w; w.x = pk2(sc[2 * kk][qs][0], sc[2 * kk][qs][1]); w.y = pk2(sc[2 * kk][qs][2], sc[2 * kk][qs][3]);
            w.z = pk2(sc[2 * kk + 1][qs][0], sc[2 * kk + 1][qs][1]); w.w = pk2(sc[2 * kk + 1][qs][2], sc[2 * kk + 1][qs][3]); Pf[qs] = __builtin_bit_cast(bf16x8, w); }
#pragma unroll
        for (int d = 0; d < 4; ++d) {
            const LAS unsigned char* vp = VT + (d * 16) * 144 + (kk * 32) * 2;
            const s16x4 lo = *(const LAS s16x4*)vp, hi = *(const LAS s16x4*)(vp + 32);
            const bf16x8 Vf = {lo[0], lo[1], lo[2], lo[3], hi[0], hi[1], hi[2], hi[3]};
#pragma unroll
            for (int qs = 0; qs < 2; ++qs) O[d][qs] = MFMA16(Vf, Pf[qs], O[d][qs]);
            __builtin_amdgcn_sched_barrier(0);
        }
    }
    __builtin_amdgcn_s_setprio(0);
}

__device__ __forceinline__ void nsa_fetch(u32x4& kv, u32x4& vv, const bf16_t* kbase, size_t kstride, const bf16_t* vtbase, size_t vstride, int tid) {
    const int row = tid >> 3, ch = tid & 7;
    kv = *(const u32x4*)(kbase + (size_t)row * kstride + ch * 8);
    vv = *(const u32x4*)(vtbase + (size_t)row * vstride + ch * 8);
}
__device__ __forceinline__ void nsa_commit(LAS unsigned char* lds, const u32x4 kv, const u32x4 vv, int tid) {
    const int row = tid >> 3, ch = tid & 7;
    *(LAS u32x4*)(lds + NS_KT + row * 144 + ch * 16) = kv;
    *(LAS u32x4*)(lds + NS_VT + row * 144 + ch * 16) = vv;
}

__device__ __forceinline__ void nsa_phase(LAS unsigned char* lds, const Args& a, const bf16_t* z, const bf16_t* KC, const bf16_t* VCT, const bf16_t* VST, const bf16_t* VWT, bf16_t* A2, int ldo, bool merged) {
    const int tid = threadIdx.x, lane = tid & 63, wid = __builtin_amdgcn_readfirstlane(tid >> 6);
    const int l15_ = lane & 15, g4_ = lane >> 4, hr = wid >> 1, qh = wid & 1;
    LAS float* IMP = (LAS float*)(lds + NS_IMP);
    LAS unsigned* SELM = (LAS unsigned*)(lds + NS_SELM);
    LAS unsigned* UNI = (LAS unsigned*)(lds + NS_UNI);
    const float* gbias = a.in[7];
#ifndef NSA_REP
#define NSA_REP 1
#endif
    const bool kc_resident = (gridDim.x & 31) == 0;
    if (kc_resident) {
        const int bg0 = (int)blockIdx.x & 31;
        __syncthreads();
#pragma unroll
        for (int it = 0; it < 4; ++it) {
            const int row = it * 64 + (tid >> 3), ch = tid & 7;
            *(LAS u32x4*)(lds + NS_KCL + row * 144 + ch * 16) = *(const u32x4*)(KC + ((size_t)bg0 * 256 + row) * 256 + ch * 8);
            const int dim = tid >> 3, c16 = (tid & 7) + 8 * it;
            *(LAS u32x4*)(lds + NS_VCL + dim * 528 + c16 * 16) = *(const u32x4*)(VCT + ((size_t)bg0 * 64 + dim) * 256 + c16 * 8);
        }
    }
    const int nun = merged ? (((int)blockIdx.x < 128) ? 7 : 9) : (2048 * NSA_REP - (int)blockIdx.x + (int)gridDim.x - 1) / (int)gridDim.x;
    for (int ui = 0; ui < nun; ++ui) {
        const int uu = merged ? ((ui < 8) ? (int)blockIdx.x + 256 * ui : (int)blockIdx.x - 128 + 1792) : (int)blockIdx.x + ui * (int)gridDim.x;
        const int unit = uu & 2047;
        const int bg = unit & 31, qt = ((unit >> 8) & 1) ? ((unit >> 5) ^ 7) : (unit >> 5), b = bg >> 1, g = bg & 1, t0 = qt * 64, cur = qt;
        const int hq = g * 4 + hr;
        const float slope = exp2f(-(float)(hq + 1)) * 1.4426950408889634f;
        const size_t row0 = (size_t)b * SEQ + t0;
        int l15 = l15_, g4 = g4_; asm volatile("" : "+v"(l15), "+v"(g4));
        int tidv = tid; asm volatile("" : "+v"(tidv));
        unsigned kt_off = NS_KT + l15 * 144 + g4 * 16, vt_off = NS_VT + l15 * 144 + g4 * 8;
        unsigned kcl_off = NS_KCL + l15 * 144 + g4 * 16, vcl_off = NS_VCL + l15 * 528 + g4 * 8;
        asm volatile("" : "+v"(kcl_off), "+v"(vcl_off));
        __syncthreads();
        if (!kc_resident) {
#pragma unroll
            for (int it = 0; it < 4; ++it) {
                const int row = it * 64 + (tid >> 3), ch = tid & 7;
                *(LAS u32x4*)(lds + NS_KCL + row * 144 + ch * 16) = *(const u32x4*)(KC + ((size_t)bg * 256 + row) * 256 + ch * 8);
                const int dim = tid >> 3, c16 = (tid & 7) + 8 * it;
                *(LAS u32x4*)(lds + NS_VCL + dim * 528 + c16 * 16) = *(const u32x4*)(VCT + ((size_t)bg * 64 + dim) * 256 + c16 * 8);
            }
        }
        if (tid == 0) { UNI[0] = 0u; UNI[1] = 0u; }
        bf16x8 Qf[2][2]; int tq[2]; float gate[2][3];
#pragma unroll
        for (int qs = 0; qs < 2; ++qs) {
            const int ql = qh * 32 + qs * 16 + l15; tq[qs] = t0 + ql;
            const bf16_t* zr = z + (row0 + ql) * ZLD;
            Qf[qs][0] = *(const bf16x8*)(zr + ZQ + hq * 64 + g4 * 8);
            Qf[qs][1] = *(const bf16x8*)(zr + ZQ + hq * 64 + 32 + g4 * 8);
#pragma unroll
            for (int br = 0; br < 3; ++br) gate[qs][br] = sigm(bf2f(zr[ZGT + hq * 3 + br]) + gbias[hq * 3 + br]);
        }
        f32x4 Y[4][2];
#pragma unroll
        for (int d = 0; d < 4; ++d) { Y[d][0] = (f32x4){0.f, 0.f, 0.f, 0.f}; Y[d][1] = Y[d][0]; }
        __syncthreads();
#ifndef NSA_NO_CMP
        const int tlmax = (4 * qt + 2) >> 6;
#pragma unroll
        for (int qs = 0; qs < 2; ++qs) {
            f32x4 sc[4][4];
            float mx = -1e30f;
#pragma unroll
            for (int tl = 0; tl < 4; ++tl) {
                if (tl <= tlmax) {
#pragma unroll
                    for (int s = 0; s < 4; ++s) {
                        const LAS unsigned char* kp = lds + kcl_off + (tl * 64 + s * 16) * 144;
                        const bf16x8 k0 = *(const LAS bf16x8*)kp, k1 = *(const LAS bf16x8*)(kp + 64);
                        const float cb = slope * (float)((tl * 1024 + s * 256 + 64 * g4 + 31) - tq[qs]);
                        f32x4 zz;
#pragma unroll
                        for (int i = 0; i < 4; ++i) zz[i] = fmaf(slope, 16.f * (float)i, cb);
                        zz = MFMA16(k0, Qf[qs][0], zz);
                        zz = MFMA16(k1, Qf[qs][1], zz);
                        if (!((64 * (tl + 1) - 1) <= (4 * qt - 2))) {
#pragma unroll
                            for (int i = 0; i < 4; ++i) {
                                const int dist = (tq[qs] - 31 - 64 * g4) - (tl * 1024 + s * 256 + 16 * i);
                                const bool ok = (dist >= 0) && !(tl == 3 && s == 3 && i == 3 && g4 == 3);
                                zz[i] = ok ? zz[i] : -1e30f;
                            }
                        }
#pragma unroll
                        for (int i = 0; i < 4; ++i) mx = fmaxf(mx, zz[i]);
                        sc[tl][s] = zz;
                        __builtin_amdgcn_sched_barrier(0);
                    }
                } else {
#pragma unroll
                    for (int s = 0; s < 4; ++s) sc[tl][s] = (f32x4){-1e30f, -1e30f, -1e30f, -1e30f};
                }
            }
            mx = fmaxf(mx, __shfl_xor(mx, 16)); mx = fmaxf(mx, __shfl_xor(mx, 32));
            const float mxx = fmaxf(mx, -1e29f);
            float ps = 0.f;
#pragma unroll
            for (int tl = 0; tl < 4; ++tl) {
                if (tl <= tlmax) {
#pragma unroll
                    for (int s = 0; s < 4; ++s)
#pragma unroll
                        for (int i = 0; i < 4; ++i) { const float p = __builtin_amdgcn_exp2f(sc[tl][s][i] - mxx); sc[tl][s][i] = p; ps += p; }
                } else {
#pragma unroll
                    for (int s = 0; s < 4; ++s) sc[tl][s] = (f32x4){0.f, 0.f, 0.f, 0.f};
                }
            }
            ps += __shfl_xor(ps, 16); ps += __shfl_xor(ps, 32);
            const float inv = ps > 0.f ? 1.f / ps : 0.f;
            unsigned imp_off = (unsigned)((hr * 64 + qh * 32 + qs * 16 + l15) * 65 + g4) * 4u; asm volatile("" : "+v"(imp_off));
            LAS float* impw = (LAS float*)(lds + NS_IMP + imp_off);
            float prev3 = 0.f;
#pragma unroll
            for (int tl = 0; tl < 4; ++tl) {
                if (tl <= tlmax) {
#pragma unroll
                    for (int s = 0; s < 4; ++s) {
                        f32x4 p = sc[tl][s] * inv; sc[tl][s] = p;
                        const float from_same = __shfl(p[3], (lane + 48) & 63);
                        const float from_prev = __shfl(prev3, (lane + 48) & 63);
                        const float p3m = (g4 > 0) ? from_same : from_prev;
                        impw[tl * 16 + s * 4] = p3m + 2.f * (p[0] + p[1] + p[2]) + p[3];
                        prev3 = p[3];
                    }
                } else {
#pragma unroll
                    for (int s = 0; s < 4; ++s) {
                        const float from_prev = __shfl(prev3, (lane + 48) & 63);
                        impw[tl * 16 + s * 4] = (g4 > 0) ? 0.f : from_prev;
                        prev3 = 0.f;
                    }
                }
            }
            f32x4 Oc[4];
#pragma unroll
            for (int d = 0; d < 4; ++d) Oc[d] = (f32x4){0.f, 0.f, 0.f, 0.f};
#pragma unroll
            for (int kk = 0; kk < 8; ++kk) {
                const int tl = kk >> 1, s0 = (kk & 1) * 2;
                if (tl <= tlmax) {
                    u32x4 w; w.x = pk2(sc[tl][s0][0], sc[tl][s0][1]); w.y = pk2(sc[tl][s0][2], sc[tl][s0][3]); w.z = pk2(sc[tl][s0 + 1][0], sc[tl][s0 + 1][1]); w.w = pk2(sc[tl][s0 + 1][2], sc[tl][s0 + 1][3]);
                    const bf16x8 Pf = __builtin_bit_cast(bf16x8, w);
#pragma unroll
                    for (int d = 0; d < 4; ++d) {
                        const LAS unsigned char* vp = lds + vcl_off + (d * 16) * 528 + (kk * 32) * 2;
                        const s16x4 lo = *(const LAS s16x4*)vp, hi = *(const LAS s16x4*)(vp + 32);
                        const bf16x8 Vf = {lo[0], lo[1], lo[2], lo[3], hi[0], hi[1], hi[2], hi[3]};
                        Oc[d] = MFMA16(Vf, Pf, Oc[d]);
                    }
                    __builtin_amdgcn_sched_barrier(0);
                }
            }
#pragma unroll
            for (int d = 0; d < 4; ++d) Y[d][qs] = Y[d][qs] + Oc[d] * gate[qs][0];
        }
#endif
        __syncthreads();
#ifndef NSA_NO_TOPK
        for (int qi = 0; qi < 8; ++qi) {
            const int q = wid * 8 + qi, j = lane;
            const float imp = ((IMP[(0 * 64 + q) * 65 + j] + IMP[(1 * 64 + q) * 65 + j]) + IMP[(2 * 64 + q) * 65 + j]) + IMP[(3 * 64 + q) * 65 + j];
            const bool forced = (j == 0) || (j == cur) || (j == cur - 1);
            const bool valid = (j <= cur);
            unsigned key = forced ? 0xFFFFFFC0u : (valid ? (__float_as_uint(fmaxf(imp, 0.f)) & 0xFFFFFFC0u) : 0u);
            key |= (unsigned)(63 - j);
            int rank = 0;
#pragma unroll 8
            for (int jp = 0; jp <= cur; ++jp) { const unsigned kj = (unsigned)__builtin_amdgcn_readlane((int)key, jp); rank += (kj > key) ? 1 : 0; }
            const unsigned long long mk = __ballot((rank < 16) && valid);
            if (lane == 0) { SELM[2 * q] = (unsigned)mk; SELM[2 * q + 1] = (unsigned)(mk >> 32); atomicOr((unsigned*)&UNI[0], (unsigned)mk); atomicOr((unsigned*)&UNI[1], (unsigned)(mk >> 32)); }
        }
#endif
        __syncthreads();
        const unsigned long long uni = ((unsigned long long)(unsigned)__builtin_amdgcn_readfirstlane((int)UNI[1]) << 32) | (unsigned)__builtin_amdgcn_readfirstlane((int)UNI[0]);
        unsigned long long msk[2];
#pragma unroll
        for (int qs = 0; qs < 2; ++qs) { const int ql = qh * 32 + qs * 16 + l15; msk[qs] = ((unsigned long long)SELM[2 * ql + 1] << 32) | SELM[2 * ql]; }
#ifndef NSA_NO_SEL
        {
            f32x4 O[4][2]; float mrun[2] = {-1e30f, -1e30f}, lrun[2] = {0.f, 0.f};
#pragma unroll
            for (int d = 0; d < 4; ++d) { O[d][0] = (f32x4){0.f, 0.f, 0.f, 0.f}; O[d][1] = O[d][0]; }
            unsigned long long rem = uni & ((cur >= 63) ? ~0ull : ((2ull << cur) - 1ull));
            u32x4 pkv = {0u, 0u, 0u, 0u}, pvv = pkv;
            int j = -1;
            if (rem) { j = __builtin_ctzll(rem); rem &= rem - 1ull;
                nsa_fetch(pkv, pvv, z + ((size_t)b * SEQ + j * 64) * ZLD + ZKS + g * 64, ZLD, VST + ((size_t)(b * 128 + g * 64)) * SEQ + j * 64, SEQ, tidv); }
            while (j >= 0) {
                __syncthreads();
                nsa_commit(lds, pkv, pvv, tidv);
                __syncthreads();
                const int jc = j;
                if (rem) { j = __builtin_ctzll(rem); rem &= rem - 1ull;
                    nsa_fetch(pkv, pvv, z + ((size_t)b * SEQ + j * 64) * ZLD + ZKS + g * 64, ZLD, VST + ((size_t)(b * 128 + g * 64)) * SEQ + j * 64, SEQ, tidv); }
                else j = -1;
                const bool selb[2] = {(bool)((msk[0] >> jc) & 1ull), (bool)((msk[1] >> jc) & 1ull)};
                flash_tile<1>(lds, kt_off, vt_off, Qf, O, mrun, lrun, slope, tq, jc * 64, selb, l15, g4, jc < cur);
            }
#pragma unroll
            for (int qs = 0; qs < 2; ++qs) {
                float l = lrun[qs]; l += __shfl_xor(l, 16); l += __shfl_xor(l, 32);
                const float sc1 = l > 0.f ? gate[qs][1] / l : 0.f;
#pragma unroll
                for (int d = 0; d < 4; ++d) Y[d][qs] = Y[d][qs] + O[d][qs] * sc1;
            }
        }
#endif
#ifndef NSA_NO_WIN
        {
            f32x4 O[4][2]; float mrun[2] = {-1e30f, -1e30f}, lrun[2] = {0.f, 0.f};
#pragma unroll
            for (int d = 0; d < 4; ++d) { O[d][0] = (f32x4){0.f, 0.f, 0.f, 0.f}; O[d][1] = O[d][0]; }
            const bool selb[2] = {true, true};
            u32x4 pkv, pvv;
            int j = (cur > 8 ? cur - 8 : 0);
            nsa_fetch(pkv, pvv, z + ((size_t)b * SEQ + j * 64) * ZLD + ZKW + g * 64, ZLD, VWT + ((size_t)(b * 128 + g * 64)) * SEQ + j * 64, SEQ, tidv);
            for (; j <= cur; ++j) {
                __syncthreads();
                nsa_commit(lds, pkv, pvv, tidv);
                __syncthreads();
                if (j < cur) nsa_fetch(pkv, pvv, z + ((size_t)b * SEQ + (j + 1) * 64) * ZLD + ZKW + g * 64, ZLD, VWT + ((size_t)(b * 128 + g * 64)) * SEQ + (j + 1) * 64, SEQ, tidv);
                flash_tile<2>(lds, kt_off, vt_off, Qf, O, mrun, lrun, slope, tq, j * 64, selb, l15, g4, (j < cur) && (j > cur - 8));
            }
#pragma unroll
            for (int qs = 0; qs < 2; ++qs) {
                float l = lrun[qs]; l += __shfl_xor(l, 16); l += __shfl_xor(l, 32);
                const float sc2 = l > 0.f ? gate[qs][2] / l : 0.f;
#pragma unroll
                for (int d = 0; d < 4; ++d) Y[d][qs] = Y[d][qs] + O[d][qs] * sc2;
            }
        }
#endif
#pragma unroll
        for (int qs = 0; qs < 2; ++qs) {
            bf16_t* op = A2 + (row0 + qh * 32 + qs * 16 + l15) * (size_t)ldo + hq * 64 + 4 * g4;
#pragma unroll
            for (int d = 0; d < 4; ++d) { u32x2 w; w.x = pk2(Y[d][qs][0], Y[d][qs][1]); w.y = pk2(Y[d][qs][2], Y[d][qs][3]); *(u32x2*)(op + d * 16) = w; }
        }
    }
}

__device__ __forceinline__ void rwkv_post(const Args& a, const bf16_t* z, const bf16_t* lo, const float* yraw, bf16_t* A2, const bf16_t* A2N) {
    const int tid = threadIdx.x, c8 = (tid & 7) * 8, h = (tid >> 3) & 7, tk = tid >> 6, hc = h * 64 + c8;
    float mur[8], muk[8], muv[8], a0v[8], kav[8], rkv[8], lw[8], lb[8];
#pragma unroll
    for (int i = 0; i < 8; ++i) { mur[i] = a.in[16][hc + i]; muk[i] = a.in[16][512 + hc + i]; muv[i] = a.in[16][1024 + hc + i];
        a0v[i] = a.in[19][hc + i]; kav[i] = a.in[23][hc + i]; rkv[i] = a.in[24][hc + i]; lw[i] = a.in[25][hc + i]; lb[i] = a.in[26][hc + i]; }
    u32x4 ncr, nck, ncv, npr, npk, npv, nla, nlg, nyw, nan_ = {0u, 0u, 0u, 0u};
#define PP_LOAD(it_) do { const size_t row_ = (size_t)(it_) * 8 + tk; const int t_ = (int)(row_ & (SEQ - 1)); const bf16_t* zr_ = z + row_ * ZLD; \
        ncr = *(const u32x4*)(zr_ + ZR + hc); nck = *(const u32x4*)(zr_ + ZK + hc); ncv = *(const u32x4*)(zr_ + ZV + hc); \
        npr = (u32x4){0u, 0u, 0u, 0u}; npk = npr; npv = npr; \
        if (t_ > 0) { const bf16_t* zp_ = zr_ - ZLD; npr = *(const u32x4*)(zp_ + ZR + hc); npk = *(const u32x4*)(zp_ + ZK + hc); npv = *(const u32x4*)(zp_ + ZV + hc); } \
        nla = *(const u32x4*)(lo + row_ * 1536 + 512 + hc); nlg = *(const u32x4*)(lo + row_ * 1536 + 1024 + hc); \
        nyw = *(const u32x4*)((const bf16_t*)yraw + row_ * 512 + hc); if (A2N) nan_ = *(const u32x4*)(A2N + row_ * 512 + hc); } while (0)
    if ((int)blockIdx.x < NTOK / 8) PP_LOAD(blockIdx.x);
    for (int it = blockIdx.x; it < NTOK / 8; it += gridDim.x) {
        const size_t row = (size_t)it * 8 + tk;
        const u32x4 cr = ncr, ck = nck, cv = ncv, pr = npr, pk = npk, pv = npv, la = nla, lg = nlg, yw = nyw, an = nan_;
        if (it + (int)gridDim.x < NTOK / 8) PP_LOAD(it + (int)gridDim.x);
        float fr_[8], fk[8], fv[8], gr[8], gk[8], gv[8], fla[8], fg[8];
        unpack8(cr, fr_); unpack8(ck, fk); unpack8(cv, fv); unpack8(pr, gr); unpack8(pk, gk); unpack8(pv, gv); unpack8(la, fla); unpack8(lg, fg);
        float y[8]; unpack8(yw, y);
        if (A2N) *(u32x4*)(A2 + row * DM + hc) = an;
        float bon = 0.f, sm = 0.f;
#pragma unroll
        for (int i = 0; i < 8; ++i) {
            fr_[i] = fr_[i] + (gr[i] - fr_[i]) * mur[i]; fk[i] = fk[i] + (gk[i] - fk[i]) * muk[i]; fv[i] = fv[i] + (gv[i] - fv[i]) * muv[i];
            const float av = sigm(a0v[i] + fla[i]);
            const float k2 = fk[i] * (1.f + (av - 1.f) * kav[i]);
            bon += fr_[i] * k2 * rkv[i]; sm += y[i];
        }
        bon += __shfl_xor(bon, 1); bon += __shfl_xor(bon, 2); bon += __shfl_xor(bon, 4);
        sm += __shfl_xor(sm, 1); sm += __shfl_xor(sm, 2); sm += __shfl_xor(sm, 4);
        const float mean = sm * (1.f / 64.f);
        float vs = 0.f;
#pragma unroll
        for (int i = 0; i < 8; ++i) { const float d = y[i] - mean; vs += d * d; }
        vs += __shfl_xor(vs, 1); vs += __shfl_xor(vs, 2); vs += __shfl_xor(vs, 4);
        const float rstd = rsqrtf(vs * (1.f / 64.f) + GN_EPS);
        float o[8];
#pragma unroll
        for (int i = 0; i < 8; ++i) o[i] = ((y[i] - mean) * rstd * lw[i] + lb[i] + bon * fv[i]) * fg[i];
        *(u32x4*)(A2 + row * DM + 512 + hc) = pack8(o);
    }
}

template <bool BASE_BF16>
__device__ __forceinline__ void row_pass(const void* base, const bf16_t* src, const float* psq, const float* gain, bf16_t* xb, float* rs_out, int gw, int NGW, int lane) {
    f32x4 gn[4];
#pragma unroll
    for (int j = 0; j < 4; ++j) gn[j] = *(const f32x4*)(gain + 4 * lane + 256 * j);
    f32x4 xa[4]; u32x2 sa[4]; float pa = 0.f;
#define RP_LOAD(m_, xv_, sv_, pq_) do { _Pragma("unroll") for (int j = 0; j < 4; ++j) { const size_t off = (size_t)(m_) * DM + 4 * lane + 256 * j; \
        if (BASE_BF16) { const u32x2 bw = *(const u32x2*)((const bf16_t*)base + off); xv_[j] = (f32x4){bf_lo(bw.x), bf_hi(bw.x), bf_lo(bw.y), bf_hi(bw.y)}; } \
        else xv_[j] = *(const f32x4*)((const float*)base + off); \
        sv_[j] = *(const u32x2*)(src + off); } \
        pq_ = (lane < 16) ? psq[(size_t)(m_) * 16 + lane] : 0.f; } while (0)
    if (gw < NTOK) RP_LOAD(gw, xa, sa, pa);
    for (int m = gw; m < NTOK; m += NGW) {
        f32x4 xn[4]; u32x2 sn[4]; float pn = 0.f;
        if (m + NGW < NTOK) RP_LOAD(m + NGW, xn, sn, pn);
        const float s = wave_sum(pa);
        const float rsm = rsqrtf(s * (1.f / DM) + NORM_EPS);
        float ss = 0.f;
#pragma unroll
        for (int j = 0; j < 4; ++j) {
            const size_t off = (size_t)m * DM + 4 * lane + 256 * j;
            const f32x4 sv = {bf_lo(sa[j].x), bf_hi(sa[j].x), bf_lo(sa[j].y), bf_hi(sa[j].y)};
            const f32x4 o = xa[j] + sv * rsm * gn[j];
            ss += o[0] * o[0] + o[1] * o[1] + o[2] * o[2] + o[3] * o[3];
            u32x2 w; w.x = pk2(o[0], o[1]); w.y = pk2(o[2], o[3]);
            *(u32x2*)(xb + off) = w;
        }
        if (rs_out) { ss = wave_sum(ss); if (lane == 0) rs_out[m] = rsqrtf(ss * (1.f / DM) + NORM_EPS); }
#pragma unroll
        for (int j = 0; j < 4; ++j) { xa[j] = xn[j]; sa[j] = sn[j]; }
        pa = pn;
    }
#undef RP_LOAD
}

#define XB_TMO      128
#define XB_XCNT(j)  (256  + 64 * (j))
#define XB_XSUB(j)  (1280 + 64 * (j))
#define XB_XGEN(j)  (2304 + 64 * (j))
#define XB_TOP      3328
#define XB_TOPGEN   3392
#define XCD_BAR_WORDS 3456
#define XB_SPIN_CAP (1u << 18)

__device__ __forceinline__ unsigned xb_ld(unsigned* p)              { return __hip_atomic_load(p, __ATOMIC_RELAXED, __HIP_MEMORY_SCOPE_AGENT); }
__device__ __forceinline__ unsigned xb_add(unsigned* p, unsigned v) { return __hip_atomic_fetch_add(p, v, __ATOMIC_RELAXED, __HIP_MEMORY_SCOPE_AGENT); }
__device__ __forceinline__ unsigned xb_xcc_id() { return (unsigned)__builtin_amdgcn_s_getreg((3 << 11) | 20) & 0xFu; }
#define XB_SPIN(cond, bar) do { unsigned _sp = 0; while (cond) { __builtin_amdgcn_s_sleep(1); \
    if ((++_sp & 255u) == 0u) { if (xb_ld(&(bar)[XB_TMO])) break; if (_sp > XB_SPIN_CAP) { atomicAdd(&(bar)[XB_TMO], 1u); break; } } } } while (0)

struct XcdBarrier {
    unsigned* bar; unsigned x;
    volatile LAS unsigned* st;
};

__device__ __forceinline__ XcdBarrier xcd_barrier_post(unsigned* bar, volatile LAS unsigned* st) {
    XcdBarrier b; b.bar = bar; b.x = xb_xcc_id(); b.st = st;
    if (threadIdx.x == 0) (void)xb_add(&bar[XB_XCNT(b.x)], 1u);
    return b;
}
__device__ __forceinline__ void xcd_barrier_complete(unsigned* bar, unsigned x, unsigned& nloc, unsigned& nx) {
    const unsigned G = gridDim.x * gridDim.y * gridDim.z;
    unsigned sum, cnt, mine, sp = 0u;
    for (;;) {
        sum = 0u; cnt = 0u; mine = 0u;
#pragma unroll
        for (unsigned j = 0; j < 16; ++j) { const unsigned c = xb_ld(&bar[XB_XCNT(j)]); sum += c; cnt += (c > 0u) ? 1u : 0u; mine = (j == x) ? c : mine; }
        if (sum == G) break;
        __builtin_amdgcn_s_sleep(1);
        if ((++sp & 255u) == 0u) { if (xb_ld(&bar[XB_TMO])) break; if (sp > XB_SPIN_CAP) { atomicAdd(&bar[XB_TMO], 1u); break; } }
    }
    nloc = mine > 0u ? mine : 1u; nx = cnt > 0u ? cnt : 1u;
}

__device__ __forceinline__ void xcd_barrier(const XcdBarrier& b) {
    asm volatile("s_waitcnt vmcnt(0)" ::: "memory");
    __syncthreads();
    if (threadIdx.x == 0) {
        unsigned* bar = b.bar;
        __builtin_amdgcn_s_waitcnt(0);
        unsigned nloc = b.st[0], nx = b.st[1];
        if (nloc == 0u) { xcd_barrier_complete(bar, b.x, nloc, nx); b.st[0] = nloc; b.st[1] = nx; }
        const unsigned old = xb_add(&bar[XB_XSUB(b.x)], 1u);
        const unsigned gen = old / nloc;
        if (old + 1u == (gen + 1u) * nloc) {
            __builtin_amdgcn_fence(__ATOMIC_RELEASE, "agent");
            asm volatile("s_waitcnt vmcnt(0)" ::: "memory");
            const unsigned og = xb_add(&bar[XB_TOP], 1u);
            const unsigned tg = og / nx;
            if (og + 1u == (tg + 1u) * nx) xb_add(&bar[XB_TOPGEN], 1u);
            else XB_SPIN(xb_ld(&bar[XB_TOPGEN]) == tg, bar);
            __builtin_amdgcn_fence(__ATOMIC_ACQUIRE, "agent");
            xb_add(&bar[XB_XGEN(b.x)], 1u);
            asm volatile("s_waitcnt vmcnt(0)" ::: "memory");
        } else {
            XB_SPIN(xb_ld(&bar[XB_XGEN(b.x)]) == gen, bar);
            __builtin_amdgcn_fence(__ATOMIC_ACQUIRE, "agent");
            asm volatile("s_waitcnt vmcnt(0)" ::: "memory");
        }
    }
    __syncthreads();
}

__global__ void __launch_bounds__(512, 2) hymba_fwd(Args a) {
    extern __shared__ __attribute__((aligned(16))) unsigned char lds_raw[];
    LAS unsigned char* lds = (LAS unsigned char*)lds_raw;
    cg::grid_group grid = cg::this_grid();
    const int tid = threadIdx.x, lane = tid & 63, wid = __builtin_amdgcn_readfirstlane(tid >> 6);
    const int G = gridDim.x, bx = blockIdx.x, gw = bx * 8 + wid, NGW = G * 8;
    unsigned char* ws = a.ws;
    bf16_t* WIN_T = (bf16_t*)(ws + WS_WIN); bf16_t* WOUT_T = (bf16_t*)(ws + WS_WOUT); bf16_t* WUP_T = (bf16_t*)(ws + WS_WUP); bf16_t* WDN_T = (bf16_t*)(ws + WS_WDN);
    bf16_t* WPLE_T = (bf16_t*)(ws + WS_WPLE); bf16_t* WPG_T = (bf16_t*)(ws + WS_WPG);
    bf16_t* CK1_T = (bf16_t*)(ws + WS_CK1); bf16_t* CV1_T = (bf16_t*)(ws + WS_CV1); bf16_t* CK2_T = (bf16_t*)(ws + WS_CK2); bf16_t* CV2_T = (bf16_t*)(ws + WS_CV2); bf16_t* LORA_T = (bf16_t*)(ws + WS_LORAT);
    float* BIAS1 = (float*)(ws + WS_BIAS1); float* RS1 = (float*)(ws + WS_RS1); float* RS2 = (float*)(ws + WS_RS2); float* PSQ = (float*)(ws + WS_PSQ);
    bf16_t* CHK = (bf16_t*)(ws + WS_CHK); bf16_t* CHV = (bf16_t*)(ws + WS_CHV); bf16_t* KC = (bf16_t*)(ws + WS_KC); bf16_t* VCT = (bf16_t*)(ws + WS_VCT);
    bf16_t* VST = (bf16_t*)(ws + WS_VST); bf16_t* VWT = (bf16_t*)(ws + WS_VWT);
    bf16_t* PB = (bf16_t*)(ws + WS_PB); bf16_t* LORA_A = (bf16_t*)(ws + WS_LORAA);
    bf16_t* RB = (bf16_t*)(ws + WS_RB); bf16_t* RC = (bf16_t*)(ws + WS_RC); bf16_t* RA = (bf16_t*)(ws + WS_RA);
    bf16_t* Z = RA; bf16_t* LORA_O = (bf16_t*)a.out;
    const int lo = a.ph_lo, hi = a.ph_hi;
#ifndef PHMASK
#define PHMASK 0xFFF
#endif
#define IN(k) (((PHMASK >> (k)) & 1) && lo <= (k) && (k) < hi)
    volatile LAS unsigned* xst = (volatile LAS unsigned*)(lds + LDS_BYTES - 16);
    if (tid == 0) { xst[0] = 0u; xst[1] = 0u; }
    __syncthreads();
    if (bx == 0) for (int i = tid; i < 4096; i += 512) ((unsigned*)ws)[i] = 0u;
    grid.sync();
    const XcdBarrier xbar = xcd_barrier_post((unsigned*)ws, xst);
#define SEAM(k) do { if (IN(k) && IN((k) + 1)) xcd_barrier(xbar); } while (0)
    const Epi<0> proto0{nullptr, 0, nullptr, nullptr, nullptr, nullptr, nullptr, nullptr};
    (void)proto0;

    if (IN(0)) {
        LAS float* scr = (LAS float*)(lds + wid * 16384);
        const float* w_in = a.in[6];
        tr_matrix(w_in, 1024, 3096, 0, 512, WIN_T, 1024, 0, 0, a.in[2], 0.125f * 1.4426950408889634f, scr, gw, NGW, lane);
        tr_matrix(w_in, 1024, 3096, 512, 384, WIN_T, 1024, 512, 0, a.in[2], 1.f, scr, gw, NGW, lane);
        tr_matrix(w_in, 1024, 3096, 896, 128, WIN_T, 1024, ZVS, 0, a.in[2], 1.f, scr, gw, NGW, lane);
        tr_matrix(w_in, 1024, 3096, 1024, 128, WIN_T, 1024, ZKW, 0, a.in[2], 1.f, scr, gw, NGW, lane);
        tr_matrix(w_in, 1024, 3096, 1152, 128, WIN_T, 1024, ZVW, 0, a.in[2], 1.f, scr, gw, NGW, lane);
        tr_matrix(w_in, 1024, 3096, 1280, 24, WIN_T, 1024, ZGT, 0, a.in[2], 1.f, scr, gw, NGW, lane);
        tr_matrix(w_in, 1024, 3096, 1304, 1792, WIN_T, 1024, ZR, 0, a.in[2], 1.f, scr, gw, NGW, lane);
        tr_matrix(a.in[27], 1024, 1024, 0, 1024, WOUT_T, 1024, 0, 0, nullptr, 1.f, scr, gw, NGW, lane);
        tr_matrix(a.in[28], 1024, 4096, 0, 4096, WUP_T, 1024, 0, 0, a.in[4], 1.f, scr, gw, NGW, lane);
        tr_matrix(a.in[29], 4096, 1024, 0, 1024, WDN_T, 4096, 0, 0, nullptr, 1.f, scr, gw, NGW, lane);
        tr_matrix(a.in[30], 256, 1024, 0, 1024, WPLE_T, 256, 0, 0, nullptr, 1.f, scr, gw, NGW, lane);
        tr_matrix(a.in[31], 1024, 1024, 0, 1024, WPG_T, 1024, 0, 0, nullptr, 1.f, scr, gw, NGW, lane);
        tr_matrix(a.in[9], 2048, 128, 0, 128, CK1_T, 2048, 0, 0, nullptr, 1.f, scr, gw, NGW, lane);
        tr_matrix(a.in[13], 2048, 128, 0, 128, CV1_T, 2048, 0, 0, nullptr, 1.f, scr, gw, NGW, lane);
        tr_matrix(a.in[11], 128, 64, 0, 64, CK2_T, 256, 0, 0, nullptr, 1.f, scr, gw, NGW, lane);
        tr_matrix(a.in[15], 128, 64, 0, 64, CV2_T, 256, 0, 0, nullptr, 1.f, scr, gw, NGW, lane);
        tr_matrix(a.in[18], 64, 512, 0, 512, LORA_T, 256, 0, 0, nullptr, 1.f, scr, gw, NGW, lane);
        tr_matrix(a.in[20], 64, 512, 0, 512, LORA_T, 256, 512, 64, nullptr, 1.f, scr, gw, NGW, lane);
        tr_matrix(a.in[21], 128, 512, 0, 512, LORA_T, 256, 1024, 128, nullptr, 1.f, scr, gw, NGW, lane);
        for (int i = bx * 512 + tid; i < 1536 * 32 + 2 * 64 * 16; i += G * 512) {
            if (i < 1536 * 32) { const int row = i >> 5, c8 = i & 31; const int lo8 = row < 512 ? 0 : (row < 1024 ? 8 : 16), hi8 = row < 512 ? 8 : (row < 1024 ? 16 : 32);
                if (c8 < lo8 || c8 >= hi8) *(u32x4*)(LORA_T + (size_t)row * 256 + c8 * 8) = (u32x4){0u, 0u, 0u, 0u}; }
            else { const int k = i - 1536 * 32, which = k >> 10, row = (k >> 4) & 63, c8 = 16 + (k & 15);
                *(u32x4*)((which ? CV2_T : CK2_T) + (size_t)row * 256 + c8 * 8) = (u32x4){0u, 0u, 0u, 0u}; }
        }
        if (gw < 256) {
            const int which = gw >> 7, n = gw & 127;
            const float* pe = which ? a.in[12] : a.in[8]; const float* w1 = which ? a.in[13] : a.in[9]; const float* b1 = which ? a.in[14] : a.in[10];
            float s = 0.f;
            for (int k = lane; k < 2048; k += 64) s += pe[k] * w1[(size_t)k * 128 + n];
            s = wave_sum(s);
            if (lane == 0) { BIAS1[which * 256 + n] = s + b1[n]; BIAS1[which * 256 + 128 + n] = 0.f; }
        }
        bf16_t* XB = RB;
        f32x4 vn[4];
        if (gw < NTOK) { const f32x4* xr0 = (const f32x4*)(a.in[0] + (size_t)gw * DM) + lane;
#pragma unroll
            for (int j = 0; j < 4; ++j) vn[j] = xr0[64 * j]; }
        for (int m = gw; m < NTOK; m += NGW) {
            f32x4 v[4]; float s = 0.f;
#pragma unroll
            for (int j = 0; j < 4; ++j) v[j] = vn[j];
            if (m + NGW < NTOK) { const f32x4* xr1 = (const f32x4*)(a.in[0] + (size_t)(m + NGW) * DM) + lane;
#pragma unroll
                for (int j = 0; j < 4; ++j) vn[j] = xr1[64 * j]; }
#pragma unroll
            for (int j = 0; j < 4; ++j) s += (v[j][0] * v[j][0] + v[j][1] * v[j][1]) + (v[j][2] * v[j][2] + v[j][3] * v[j][3]);
            s = wave_sum(s);
            if (lane == 0) RS1[m] = rsqrtf(s * (1.f / DM) + NORM_EPS);
            u32x2* o8 = (u32x2*)(XB + (size_t)m * DM) + lane;
#pragma unroll
            for (int j = 0; j < 4; ++j) { u32x2 w; w.x = pk2(v[j][0], v[j][1]); w.y = pk2(v[j][2], v[j][3]); o8[64 * j] = w; }
        }
        for (size_t i = (size_t)bx * 512 + tid; i < (size_t)NTOK * 256 / 8; i += (size_t)G * 512) {
            const f32x4 p0 = *(const f32x4*)(a.in[1] + i * 8), p1 = *(const f32x4*)(a.in[1] + i * 8 + 4);
            u32x4 w; w.x = pk2(p0[0], p0[1]); w.y = pk2(p0[2], p0[3]); w.z = pk2(p1[0], p1[1]); w.w = pk2(p1[2], p1[3]);
            *(u32x4*)(PB + i * 8) = w;
        }
    }
    SEAM(0);
    if (IN(1)) {
        Epi<0> E{Z, ZLD, RS1, nullptr, nullptr, VST, nullptr, nullptr};
        run_gemm<0>(lds, RB, WIN_T, NTOK, ZLD, 1024, 1024, 128, 0, bx, E);
    }
    SEAM(1);
    if (IN(2)) {
        { Epi<1> E{CHK, 256, nullptr, BIAS1, nullptr, nullptr, nullptr, nullptr};
          run_gemm<1>(lds, Z + ZKC, CK1_T, 8192, 256, 2048, 16 * ZLD, (long)ZLD * 2, 1, bx, E); }
        { Epi<1> E{CHV, 256, nullptr, BIAS1 + 256, nullptr, nullptr, nullptr, nullptr};
          run_gemm<1>(lds, Z + ZVC, CV1_T, 8192, 256, 2048, 16 * ZLD, (long)ZLD * 2, 1, (bx + G / 2) % G, E); }
        const float* mu = a.in[16] + 1536;
        const bool has_cmp = (G == 256) && (bx < 32 || (bx >= 128 && bx < 160));
        const int eb = (G == 256) ? (bx < 128 ? bx - 32 : bx - 64) : bx, eG = (G == 256) ? 192 : G;
        if (!has_cmp)
        for (size_t i = (size_t)eb * 512 + tid; i < (size_t)NTOK * 32; i += (size_t)eG * 512) {
            const size_t row = i >> 5; const int col = (int)(i & 31) * 8; const int t = (int)(row & (SEQ - 1));
            const bf16_t* zr = Z + row * ZLD + ZWD + col;
            const u32x4 cw = *(const u32x4*)zr; u32x4 pw = {0u, 0u, 0u, 0u};
            if (t > 0) pw = *(const u32x4*)(zr - ZLD);
            float c[8], p[8]; unpack8(cw, c); unpack8(pw, p);
#pragma unroll
            for (int j = 0; j < 8; ++j) {
                float v = c[j] + (p[j] - c[j]) * mu[col + j];
                if (col < 64) { const float e = __expf(2.f * v); v = 1.f - 2.f / (e + 1.f); }
                else if (col >= 128) v = sigm(v);
                c[j] = v;
            }
            *(u32x4*)(LORA_A + row * 256 + col) = pack8(c);
        }
    }
    SEAM(2);
    if (IN(3)) {
#ifndef P3_SKIP1
        { Epi<2> E{LORA_O, 1536, nullptr, nullptr, nullptr, nullptr, nullptr, nullptr};
          run_gemm<2>(lds, LORA_A, LORA_T, NTOK, 1536, 256, 256, 128, 0, bx, E); }
#endif
#ifndef P3_SKIP2
        { Epi<2> E{KC, 256, nullptr, nullptr, nullptr, nullptr, nullptr, nullptr};
          run_gemm<2>(lds, CHK, CK2_T, 8192, 256, 256, 256, 128, 0, bx, E); }
#endif
#ifndef P3_SKIP3
        { Epi<3> E{nullptr, 0, nullptr, nullptr, nullptr, VCT, nullptr, nullptr};
          run_gemm<3>(lds, CHV, CV2_T, 8192, 256, 256, 256, 128, 0, (bx + G / 2) % G, E); }
#endif
    }
    SEAM(3);
#ifndef REP4
#define REP4 1
#endif
#ifndef REP5
#define REP5 1
#endif
    const bool merged45 = (G == 256) && IN(4) && IN(5);
    bf16_t* A2N = RB + (size_t)NTOK * 512;
    if (IN(4)) { scan_precompute(lds, a, Z, LORA_O); xcd_barrier(xbar); scan_phase(lds, a, Z, LORA_O, (float*)RB);
                 if (merged45) nsa_phase(lds, a, Z, KC, VCT, VST, VWT, A2N, 512, true); }
    SEAM(4);
    if (IN(5)) for (int rep = 0; rep < REP5; ++rep) {
#ifndef NO_NSA
        if (!merged45) nsa_phase(lds, a, Z, KC, VCT, VST, VWT, RC, DM, false);
#endif
#ifndef NO_POST
        rwkv_post(a, Z, LORA_O, (const float*)RB, RC, merged45 ? A2N : (const bf16_t*)nullptr);
#endif
    }
    SEAM(5);
    if (IN(6)) {
        Epi<4> E{RB, DM, nullptr, nullptr, PSQ, nullptr, nullptr, nullptr};
        run_gemm<4>(lds, RC, WOUT_T, NTOK, DM, DM, DM, 128, 0, bx, E);
    }
    SEAM(6);
    if (IN(7)) row_pass<false>(a.in[0], RB, PSQ, a.in[3], RC, RS2, gw, NGW, lane);
    SEAM(7);
    if (IN(8)) {
        Epi<5> E{RA, DFF, RS2, nullptr, nullptr, nullptr, nullptr, nullptr};
        run_gemm<5>(lds, RC, WUP_T, NTOK, DFF, DM, DM, 128, 0, bx, E);
    }
    SEAM(8);
    if (IN(9)) {
        Epi<4> E{RB, DM, nullptr, nullptr, PSQ, nullptr, nullptr, nullptr};
        run_gemm<4>(lds, RA, WDN_T, NTOK, DM, DFF, DFF, 128, 0, bx, E);
    }
    SEAM(9);
    if (IN(10)) {
        { Epi<2> E{RA, DM, nullptr, nullptr, nullptr, nullptr, nullptr, nullptr};
          run_gemm<2>(lds, PB, WPLE_T, NTOK, DM, 256, 256, 128, 0, bx, E); }
        row_pass<true>(RC, RB, PSQ, a.in[5], RC, nullptr, gw, NGW, lane);
    }
    SEAM(10);
    if (IN(11)) {
        Epi<6> E{RC, DM, nullptr, nullptr, nullptr, nullptr, a.out, RA};
        run_gemm<6>(lds, RC, WPG_T, NTOK, DM, DM, DM, 128, 0, bx, E);
    }
#undef IN
#undef SEAM
}

extern "C" void kernel_launch(void* const* d_in, const int* in_sizes, int n_in, void* d_out, int out_size, void* d_ws, size_t ws_size, hipStream_t stream) {
    static int grid = 0;
    if (grid == 0) {
        if (n_in != 32 || out_size != NTOK * DM || ws_size < (size_t)992 * MiB) { fprintf(stderr, "kernel_launch: unexpected shapes (n_in %d out %d ws %zu)\n", n_in, out_size, ws_size); grid = -1; return; }
        int dev = 0, cus = 0, per_cu = 0;
        hipGetDevice(&dev);
        hipDeviceGetAttribute(&cus, hipDeviceAttributeMultiprocessorCount, dev);
        if (hipFuncSetAttribute((const void*)hymba_fwd, hipFuncAttributeMaxDynamicSharedMemorySize, LDS_BYTES) != hipSuccess) { fprintf(stderr, "kernel_launch: hipFuncSetAttribute failed\n"); grid = -1; return; }
        hipOccupancyMaxActiveBlocksPerMultiprocessor(&per_cu, (const void*)hymba_fwd, 512, LDS_BYTES);
        (void)hipGetLastError();
        if (per_cu < 1) fprintf(stderr, "kernel_launch: occupancy query reports %d blocks per CU\n", per_cu);
        grid = cus;
    }
    if (grid < 0) return;
    Args a{};
    for (int i = 0; i < 32; ++i) a.in[i] = (const float*)d_in[i];
    a.out = (float*)d_out; a.ws = (unsigned char*)d_ws;
#if N_LAUNCH_MODE == 1
    a.ph_lo = 0; a.ph_hi = NPHASE;
    { void* args[] = {&a};
      hipError_t e = hipLaunchCooperativeKernel((const void*)hymba_fwd, dim3(grid), dim3(512), args, LDS_BYTES, stream);
      if (e != hipSuccess) fprintf(stderr, "cooperative launch failed: %s (grid %d)\n", hipGetErrorString(e), grid); }
#else
    for (int ph = 0; ph < NPHASE; ++ph) {
        a.ph_lo = ph; a.ph_hi = ph + 1;
        void* args[] = {&a};
        hipError_t e = hipLaunchCooperativeKernel((const void*)hymba_fwd, dim3(grid), dim3(512), args, LDS_BYTES, stream);
        if (e != hipSuccess) { fprintf(stderr, "launch %d failed: %s (grid %d)\n", ph, hipGetErrorString(e), grid); break; }
    }
#endif
}
```

```cpp
#include <hip/hip_runtime.h>
#include <hip/hip_cooperative_groups.h>
#include <cstdio>
#include <cstdint>
namespace cg = cooperative_groups;

#ifndef N_LAUNCH_MODE
#define N_LAUNCH_MODE 1
#endif

#define LAS __attribute__((address_space(3)))
typedef unsigned short bf16_t;
typedef short bf16x8 __attribute__((ext_vector_type(8)));
typedef short s16x4 __attribute__((ext_vector_type(4)));
typedef float f32x4 __attribute__((ext_vector_type(4)));
typedef float f32x2 __attribute__((ext_vector_type(2)));
typedef unsigned u32x4 __attribute__((ext_vector_type(4)));
typedef unsigned u32x2 __attribute__((ext_vector_type(2)));
typedef __bf16 bf16x2_t __attribute__((ext_vector_type(2)));

constexpr int NTOK = 65536, DM = 1024, SEQ = 4096, ZLD = 3328, DFF = 4096;
constexpr int ZQ = 0, ZKC = 512, ZVC = 640, ZKS = 768, ZKW = 896, ZVS = 1024, ZVW = 1152, ZR = 1280, ZK = 1792, ZV = 2304, ZWD = 2816, ZGT = 3072;
constexpr float NORM_EPS = 1e-6f, GN_EPS = 64e-5f;
constexpr int NPHASE = 12;
constexpr size_t MiB = (size_t)1 << 20;
constexpr size_t WS_WIN = 2 * MiB, WS_WOUT = 9 * MiB, WS_WUP = 11 * MiB, WS_WDN = 19 * MiB, WS_WPLE = 27 * MiB, WS_WPG = 28 * MiB;
constexpr size_t WS_ZERO = 30 * MiB, WS_ZERO_BYTES = 4 * MiB;
constexpr size_t WS_CK1 = 30 * MiB, WS_CV1 = 31 * MiB, WS_CK2 = 32 * MiB, WS_CV2 = 32 * MiB + 128 * 1024, WS_LORAT = 33 * MiB;
constexpr size_t WS_BIAS1 = 34 * MiB, WS_RS1 = 35 * MiB, WS_RS2 = 35 * MiB + 512 * 1024, WS_PSQ = 36 * MiB;
constexpr size_t WS_CHK = 40 * MiB, WS_CHV = 44 * MiB, WS_KC = 48 * MiB, WS_VCT = 52 * MiB, WS_VST = 54 * MiB, WS_VWT = 70 * MiB;
constexpr size_t WS_PB = 86 * MiB, WS_LORAA = 118 * MiB, WS_RB = 150 * MiB, WS_RC = 278 * MiB, WS_RA = 406 * MiB, WS_END = 918 * MiB;
constexpr int LDS_BYTES = 155648;

struct Args { const float* in[32]; float* out; unsigned char* ws; int ph_lo, ph_hi; };

__device__ __forceinline__ unsigned pk2(float lo, float hi) { f32x2 v = {lo, hi}; bf16x2_t b = __builtin_convertvector(v, bf16x2_t); return __builtin_bit_cast(unsigned, b); }
__device__ __forceinline__ bf16_t f2bf(float x) { return (bf16_t)(pk2(x, 0.f) & 0xffffu); }
__device__ __forceinline__ float bf_lo(unsigned w) { return __uint_as_float(w << 16); }
__device__ __forceinline__ float bf_hi(unsigned w) { return __uint_as_float(w & 0xffff0000u); }
__device__ __forceinline__ float bf2f(bf16_t h) { return __uint_as_float((unsigned)h << 16); }
__device__ __forceinline__ float sigm(float x) { return __builtin_amdgcn_rcpf(1.f + __expf(-x)); }
__device__ __forceinline__ void unpack8(const u32x4 w, float (&f)[8]) {
    f[0] = bf_lo(w.x); f[1] = bf_hi(w.x); f[2] = bf_lo(w.y); f[3] = bf_hi(w.y); f[4] = bf_lo(w.z); f[5] = bf_hi(w.z); f[6] = bf_lo(w.w); f[7] = bf_hi(w.w); }
__device__ __forceinline__ u32x4 pack8(const float (&f)[8]) { u32x4 w; w.x = pk2(f[0], f[1]); w.y = pk2(f[2], f[3]); w.z = pk2(f[4], f[5]); w.w = pk2(f[6], f[7]); return w; }
__device__ __forceinline__ float wave_sum(float v) {
#pragma unroll
    for (int o = 1; o < 64; o <<= 1) v += __shfl_xor(v, o);
    return v; }
#define LDS_WAIT() asm volatile("s_waitcnt lgkmcnt(0)" ::: "memory")

namespace pg8 {
constexpr int BM = 256, BK = 64, HALF = 128, HTB = HALF * BK * 2, STAGE_BYTES = 8 * HTB, NXCD = 8, WGM = 8;
__host__ __device__ __forceinline__ int lds_byte(int r, int c) { const int st = (r >> 4) * 2 + (c >> 5), rr = r & 15, cc = c & 31, ob = rr * 64 + cc * 2; return st * 1024 + (ob ^ (((ob >> 9) & 1) << 5)); }
__host__ __device__ __forceinline__ void stage_rc(int b, int& R, int& C) { const int st = b / 1024, sb = b % 1024, swz = sb ^ (((sb >> 9) & 1) << 5); R = (st >> 1) * 16 + swz / 64; C = (st & 1) * 32 + (swz % 64) / 2; }
__host__ __device__ __forceinline__ int perm32(int rho) { const int n = rho >> 4, i = rho & 15; return 8 * (i >> 2) + 4 * n + (i & 3); }

struct Unit { int pm, pn; };
struct Gemm { const bf16_t* A; const bf16_t* Bt; int M, N, K; long lda; long akstep; int amode; };
__device__ __forceinline__ size_t a_unit_off(const Gemm& g, int pm) {
    if (g.amode == 1) return ((size_t)(pm >> 1) * SEQ * ZLD + (size_t)(pm & 1) * 64) * 2;
    return (size_t)pm * BM * (size_t)g.lda * 2; }

struct StaticOrder {
    int nM, nN, nwg, G, c;
    __host__ __device__ void init(int M, int N, int G_, int c_) { nM = M / BM; nN = N / BM; nwg = nM * nN; G = G_; c = c_; }
    __host__ __device__ bool next(int i, Unit& u) const {
        const long L = (long)i * G + c; if (L >= nwg) return false;
        int wgid = (int)L; { const int q = nwg / NXCD, r = nwg % NXCD, xcd = wgid % NXCD, off = wgid / NXCD; wgid = (xcd < r ? xcd * (q + 1) : r * (q + 1) + (xcd - r) * q) + off; }
        const int nig = WGM * nN, gid = wgid / nig, fm = gid * WGM, gsz = (nM - fm) < WGM ? (nM - fm) : WGM;
        u.pm = fm + ((wgid % nig) % gsz); u.pn = (wgid % nig) / gsz; return true;
    }
};

template <class Epi, class Sched, bool ALIGN_EPI = true, bool SP2 = true>
__device__ __forceinline__ void gemm_phase(LAS unsigned char* lds, const Gemm g, const Sched& S, const Epi& E) {
    const int tid = threadIdx.x, wid = __builtin_amdgcn_readfirstlane(tid >> 6), lane = tid & 63, wr = wid >> 2, wc = wid & 3, fr = lane & 15, fq = lane >> 4;
    const int K = g.K, nt = K / BK;
    unsigned voffA[2], voffB[2];
#pragma unroll
    for (int i = 0; i < 2; ++i) { int R, C; stage_rc(tid * 16 + i * 8192, R, C); const int Rb = Epi::PERM ? ((R & ~31) + perm32(R & 31)) : R;
        voffA[i] = (unsigned)((long)R * g.lda + C) * 2u; voffB[i] = (unsigned)(Rb * K + C) * 2u; }
    const size_t kstepA = (size_t)g.akstep, kstepB = (size_t)(BK * 2);
    const size_t hstepA = (size_t)HALF * (size_t)g.lda * 2, hstepB = (size_t)HALF * K * 2;
    const size_t tstepB = 2 * hstepB;
    const unsigned ldsw = (unsigned)wid * 1024u;
    const int aoff = lds_byte(wr * 64 + fr, fq * 8), boff = lds_byte(wc * 32 + fr, fq * 8);
#define PG8_SA(b, h) (((b) * 2 + (h)) * HTB)
#define PG8_SB(b, h) ((4 + (b) * 2 + (h)) * HTB)
#define PG8_STAGE(bufoff, gbase, voff) do { _Pragma("unroll") for (int _i = 0; _i < 2; ++_i) \
        __builtin_amdgcn_global_load_lds((const unsigned*)((const char*)(gbase) + (voff)[_i]), (LAS unsigned*)(lds + (bufoff) + ldsw + _i * 8192), 16, 0, 0); } while (0)
#define PG8_LDA(dst, b, h) do { _Pragma("unroll") for (int m = 0; m < 4; ++m) _Pragma("unroll") for (int k = 0; k < 2; ++k) dst[m][k] = *(const LAS bf16x8*)(lds + PG8_SA(b, h) + aoff + m * 2048 + k * 1024); } while (0)
#define PG8_LDB(dst, b, h) do { _Pragma("unroll") for (int n = 0; n < 2; ++n) _Pragma("unroll") for (int k = 0; k < 2; ++k) dst[n][k] = *(const LAS bf16x8*)(lds + PG8_SB(b, h) + boff + n * 2048 + k * 1024); } while (0)
#define PG8_MMA(ai, bj, At, Bt) do { __builtin_amdgcn_s_setprio(1); _Pragma("unroll") for (int m = 0; m < 4; ++m) _Pragma("unroll") for (int n = 0; n < 2; ++n) _Pragma("unroll") for (int k = 0; k < 2; ++k) \
        acc[ai][bj][m][n] = __builtin_amdgcn_mfma_f32_16x16x32_bf16(Bt[n][k], At[m][k], acc[ai][bj][m][n], 0, 0, 0); __builtin_amdgcn_s_setprio(0); } while (0)
#define PG8_WAIT_V(n) asm volatile("s_waitcnt vmcnt(" #n ")" ::: "memory")
#define PG8_WAIT_L(n) asm volatile("s_waitcnt lgkmcnt(" #n ")" ::: "memory")
#define PG8_BAR __builtin_amdgcn_s_barrier()
#define PG8_SCHED __builtin_amdgcn_sched_barrier(0)
    Unit cur, nxt; int ui = 0;
    if (!S.next(0, cur)) return;
    f32x4 acc[2][2][4][2];
#pragma unroll
    for (int a = 0; a < 2; ++a)
#pragma unroll
        for (int b = 0; b < 2; ++b)
#pragma unroll
            for (int m = 0; m < 4; ++m)
#pragma unroll
                for (int n = 0; n < 2; ++n) acc[a][b][m][n] = (f32x4){0.f, 0.f, 0.f, 0.f};
    bf16x8 At[4][2], B0[2][2], B1[2][2];
    const char* cA = (const char*)g.A + a_unit_off(g, cur.pm); const char* cB = (const char*)g.Bt + (size_t)cur.pn * tstepB;
    if constexpr (SP2) {
        PG8_STAGE(PG8_SB(0, 0), cB, voffB); PG8_STAGE(PG8_SB(0, 1), cB + hstepB, voffB); PG8_STAGE(PG8_SA(0, 0), cA, voffA); PG8_STAGE(PG8_SA(0, 1), cA + hstepA, voffA);
        if (wr == 1) PG8_BAR;
        PG8_WAIT_V(2); PG8_BAR;
        PG8_STAGE(PG8_SB(1, 0), cB + kstepB, voffB); PG8_STAGE(PG8_SA(1, 0), cA + kstepA, voffA); PG8_STAGE(PG8_SB(1, 1), cB + hstepB + kstepB, voffB);
        PG8_WAIT_V(6); PG8_BAR;
    } else {
        PG8_STAGE(PG8_SB(0, 0), cB, voffB); PG8_STAGE(PG8_SA(0, 0), cA, voffA); PG8_STAGE(PG8_SB(0, 1), cB + hstepB, voffB); PG8_STAGE(PG8_SA(0, 1), cA + hstepA, voffA);
        if (wr == 1) PG8_BAR;
        PG8_WAIT_V(4); PG8_BAR;
        PG8_STAGE(PG8_SB(1, 0), cB + kstepB, voffB); PG8_STAGE(PG8_SA(1, 0), cA + kstepA, voffA); PG8_STAGE(PG8_SB(1, 1), cB + hstepB + kstepB, voffB);
        PG8_WAIT_V(6); PG8_BAR;
    }
    for (;;) {
        const bool has_next = S.next(ui + 1, nxt);
        const char* nA = has_next ? (const char*)g.A + a_unit_off(g, nxt.pm) : cA; const char* nB = has_next ? (const char*)g.Bt + (size_t)nxt.pn * tstepB : cB;
#pragma nounroll
        for (int t = 0; t < nt; t += 2) {
            const bool last = (t == nt - 2);
            const char* a1 = cA + (size_t)(t + 1) * kstepA;
            const char* a2 = last ? nA : cA + (size_t)(t + 2) * kstepA; const char* b2 = last ? nB : cB + (size_t)(t + 2) * kstepB;
            const char* a3 = a2 + kstepA; const char* b3 = b2 + kstepB;
            if constexpr (SP2) {
            PG8_LDB(B0, 0, 0); PG8_LDB(B1, 0, 1); PG8_SCHED; PG8_LDA(At, 0, 0); PG8_STAGE(PG8_SA(1, 1), a1 + hstepA, voffA);
            PG8_WAIT_V(8); PG8_WAIT_L(0); PG8_BAR; PG8_MMA(0, 0, At, B0); PG8_MMA(0, 1, At, B1); PG8_BAR; PG8_SCHED;
            PG8_LDA(At, 0, 1); PG8_STAGE(PG8_SB(0, 0), b2, voffB); PG8_STAGE(PG8_SB(0, 1), b2 + hstepB, voffB); PG8_STAGE(PG8_SA(0, 0), a2, voffA);
            PG8_WAIT_V(8); PG8_WAIT_L(0); PG8_BAR; PG8_MMA(1, 0, At, B0); PG8_MMA(1, 1, At, B1); PG8_BAR; PG8_SCHED;
            PG8_LDB(B0, 1, 0); PG8_LDB(B1, 1, 1); PG8_SCHED; PG8_LDA(At, 1, 0); PG8_STAGE(PG8_SA(0, 1), a2 + hstepA, voffA);
            PG8_WAIT_V(8); PG8_WAIT_L(0); PG8_BAR; PG8_MMA(0, 0, At, B0); PG8_MMA(0, 1, At, B1); PG8_BAR; PG8_SCHED;
            PG8_LDA(At, 1, 1); PG8_STAGE(PG8_SB(1, 0), b3, voffB); PG8_STAGE(PG8_SB(1, 1), b3 + hstepB, voffB); PG8_STAGE(PG8_SA(1, 0), a3, voffA);
            PG8_WAIT_V(8); PG8_WAIT_L(0); PG8_BAR; PG8_MMA(1, 0, At, B0); PG8_MMA(1, 1, At, B1); PG8_BAR; PG8_SCHED;
            } else {
            PG8_LDB(B0, 0, 0); PG8_SCHED; PG8_LDA(At, 0, 0); PG8_STAGE(PG8_SA(1, 1), a1 + hstepA, voffA);
            PG8_WAIT_L(8); PG8_BAR; PG8_WAIT_L(0); PG8_MMA(0, 0, At, B0); PG8_BAR; PG8_SCHED;
            PG8_LDB(B1, 0, 1); PG8_STAGE(PG8_SB(0, 0), b2, voffB);
            PG8_BAR; PG8_WAIT_L(0); PG8_MMA(0, 1, At, B1); PG8_BAR;
            PG8_LDA(At, 0, 1); PG8_STAGE(PG8_SA(0, 0), a2, voffA);
            PG8_BAR; PG8_WAIT_L(0); PG8_MMA(1, 0, At, B0); PG8_BAR; PG8_SCHED;
            PG8_STAGE(PG8_SB(0, 1), b2 + hstepB, voffB);
            PG8_WAIT_V(6); PG8_BAR; PG8_MMA(1, 1, At, B1); PG8_BAR;
            PG8_LDB(B0, 1, 0); PG8_SCHED; PG8_LDA(At, 1, 0); PG8_STAGE(PG8_SA(0, 1), a2 + hstepA, voffA);
            PG8_WAIT_L(8); PG8_BAR; PG8_WAIT_L(0); PG8_MMA(0, 0, At, B0); PG8_BAR; PG8_SCHED;
            PG8_LDB(B1, 1, 1); PG8_STAGE(PG8_SB(1, 0), b3, voffB);
            PG8_BAR; PG8_WAIT_L(0); PG8_MMA(0, 1, At, B1); PG8_BAR;
            PG8_LDA(At, 1, 1); PG8_STAGE(PG8_SA(1, 0), a3, voffA);
            PG8_BAR; PG8_WAIT_L(0); PG8_MMA(1, 0, At, B0); PG8_BAR; PG8_SCHED;
            PG8_STAGE(PG8_SB(1, 1), b3 + hstepB, voffB);
            PG8_WAIT_V(6); PG8_BAR; PG8_MMA(1, 1, At, B1); PG8_BAR;
            }
        }
        if constexpr (ALIGN_EPI) { if (wr == 0) PG8_BAR; }
        E(acc, cur, wr, wc, fr, fq);
        if (!has_next) break;
#pragma unroll
        for (int a = 0; a < 2; ++a)
#pragma unroll
            for (int b = 0; b < 2; ++b)
#pragma unroll
                for (int m = 0; m < 4; ++m)
#pragma unroll
                    for (int n = 0; n < 2; ++n) acc[a][b][m][n] = (f32x4){0.f, 0.f, 0.f, 0.f};
        cur = nxt; cA = nA; cB = nB; ++ui;
        if constexpr (ALIGN_EPI) { if (wr == 1) PG8_BAR; }
    }
    PG8_WAIT_V(0);
    if constexpr (!ALIGN_EPI) { if (wr == 0) PG8_BAR; }
    PG8_BAR;
#undef PG8_SA
#undef PG8_SB
#undef PG8_STAGE
#undef PG8_LDA
#undef PG8_LDB
#undef PG8_MMA
#undef PG8_WAIT_V
#undef PG8_WAIT_L
#undef PG8_BAR
#undef PG8_SCHED
}
}

template <int MODE> struct Epi {
    static constexpr bool PERM = true;
    bf16_t* O; int ldc; const float* rowscale; const float* bias; float* psq; bf16_t* OT; float* outf; const bf16_t* pe;
    __device__ __forceinline__ void operator()(const f32x4 (&acc)[2][2][4][2], const pg8::Unit& u, int wr, int wc, int fr, int fq) const {
#pragma unroll
        for (int ai = 0; ai < 2; ++ai)
#pragma unroll
            for (int m = 0; m < 4; ++m) {
                const int r = u.pm * 256 + ai * 128 + wr * 64 + m * 16 + fr;
                float rs = 1.f;
                if (MODE == 0 || MODE == 5) rs = rowscale[r];
                float ssq = 0.f;
#pragma unroll
                for (int bj = 0; bj < 2; ++bj) {
                    const int c0 = u.pn * 256 + bj * 128 + wc * 32 + 8 * fq;
                    const f32x4 a0 = acc[ai][bj][m][0], a1 = acc[ai][bj][m][1];
                    float v[8] = {a0[0], a0[1], a0[2], a0[3], a1[0], a1[1], a1[2], a1[3]};
                    if (MODE == 0) {
#pragma unroll
                        for (int j = 0; j < 8; ++j) v[j] *= rs;
                        if (u.pn == 4) {
                            const int b = r >> 12, t = r & 4095, cc = wc * 32 + 8 * fq;
                            bf16_t* vt = OT + (size_t)bj * ((size_t)16 * 128 * 4096) + ((size_t)(b * 128 + cc)) * 4096 + t;
#pragma unroll
                            for (int j = 0; j < 8; ++j) vt[(size_t)j * 4096] = f2bf(v[j]);
                        } else {
                            *(u32x4*)(O + (size_t)r * ldc + c0) = pack8(v);
                        }
                    } else if (MODE == 1) {
                        const f32x4 b0 = *(const f32x4*)(bias + c0), b1 = *(const f32x4*)(bias + c0 + 4);
                        const float bb[8] = {b0[0], b0[1], b0[2], b0[3], b1[0], b1[1], b1[2], b1[3]};
#pragma unroll
                        for (int j = 0; j < 8; ++j) { const float x = v[j] + bb[j]; const float uu = 0.7978845608028654f * (x + 0.044715f * x * x * x); v[j] = x * sigm(2.f * uu); }
                        *(u32x4*)(O + (size_t)r * ldc + c0) = pack8(v);
                    } else if (MODE == 2) {
                        *(u32x4*)(O + (size_t)r * ldc + c0) = pack8(v);
                    } else if (MODE == 3) {
                        if (u.pn == 0 && c0 < 64) {
                            const int bg = r >> 8, n = r & 255;
#pragma unroll
                            for (int j = 0; j < 8; ++j) OT[((size_t)(bg * 64 + c0 + j)) * 256 + n] = f2bf(v[j]);
                        }
                    } else if (MODE == 4) {
#pragma unroll
                        for (int j = 0; j < 8; ++j) ssq += v[j] * v[j];
                        *(u32x4*)(O + (size_t)r * ldc + c0) = pack8(v);
                    } else if (MODE == 5) {
#pragma unroll
                        for (int j = 0; j < 8; ++j) { const float x = fmaxf(v[j] * rs, 0.f); v[j] = x * x; }
                        *(u32x4*)(O + (size_t)r * ldc + c0) = pack8(v);
                    } else if (MODE == 6) {
                        float* op = outf + (size_t)r * DM + c0;
                        const u32x4 xw = *(const u32x4*)(O + (size_t)r * DM + c0);
                        float xf[8]; unpack8(xw, xf);
                        const u32x4 pw = *(const u32x4*)(pe + (size_t)r * DM + c0);
                        float pf[8]; unpack8(pw, pf);
                        f32x4 o0, o1;
#pragma unroll
                        for (int j = 0; j < 4; ++j) { o0[j] = xf[j] + sigm(v[j]) * pf[j]; o1[j] = xf[4 + j] + sigm(v[4 + j]) * pf[4 + j]; }
                        *(f32x4*)op = o0; *(f32x4*)(op + 4) = o1;
                    }
                }
                if (MODE == 4) {
                    ssq += __shfl_xor(ssq, 16); ssq += __shfl_xor(ssq, 32);
                    if (fq == 0) psq[(size_t)r * 16 + u.pn * 4 + wc] = ssq;
                }
                asm volatile("" ::: "memory");
            }
    }
};

template <int MODE>
__device__ __forceinline__ void run_gemm(LAS unsigned char* lds, const bf16_t* A, const bf16_t* Bt, int M, int N, int K, long lda, long akstep, int amode, int c, const Epi<MODE>& E) {
    pg8::Gemm g{A, Bt, M, N, K, lda, akstep, amode};
    pg8::StaticOrder S; S.init(M, N, (int)gridDim.x, c);
    pg8::gemm_phase<Epi<MODE>, pg8::StaticOrder, true, true>(lds, g, S, E);
}

__device__ __forceinline__ void tr_matrix(const float* W, int K, int ldn, int c0src, int ncols, bf16_t* WT, int ldk, int dst_row0, int dst_k0,
                                          const float* rsc, float cs, LAS float* scr, int gw, int NGW, int lane) {
    const int nkb = K / 64, nnb = (ncols + 31) / 32, nit = nkb * nnb;
    for (int it = gw; it < nit; it += NGW) {
        const int kb = it / nnb, nb = it % nnb, k0 = kb * 64, n0 = nb * 32, ncv = (ncols - n0) < 32 ? (ncols - n0) : 32;
#pragma unroll 8
        for (int i = 0; i < 32; ++i) { const int kk = 2 * i + (lane >> 5), col = lane & 31;
            float val = 0.f;
            if (col < ncv) { val = W[(size_t)(k0 + kk) * ldn + c0src + n0 + col]; if (rsc) val *= rsc[k0 + kk]; val *= cs; }
            scr[kk * 33 + col] = val; }
        LDS_WAIT(); asm volatile("" ::: "memory");
        const int c = lane & 7;
#pragma unroll
        for (int j = 0; j < 4; ++j) { const int n = (lane >> 3) + 8 * j; const LAS float* s = scr + (8 * c) * 33 + n;
            if (n < ncv) {
                u32x4 o; o.x = pk2(s[0 * 33], s[1 * 33]); o.y = pk2(s[2 * 33], s[3 * 33]); o.z = pk2(s[4 * 33], s[5 * 33]); o.w = pk2(s[6 * 33], s[7 * 33]);
                *(u32x4*)(WT + (size_t)(dst_row0 + n0 + n) * ldk + dst_k0 + k0 + 8 * c) = o; } }
        LDS_WAIT(); asm volatile("" ::: "memory");
    }
}

template <int CTRL> __device__ __forceinline__ float dppf(float x) { return __int_as_float(__builtin_amdgcn_update_dpp(0, __float_as_int(x), CTRL, 0xF, 0xF, false)); }
__device__ __forceinline__ float allred16(float x) { x += dppf<0xB1>(x); x += dppf<0x4E>(x); x += dppf<0x141>(x); x += dppf<0x140>(x); return x; }

#define MFMA16K16(a, b, c) __builtin_amdgcn_mfma_f32_16x16x16bf16_1k(a, b, c, 0, 0, 0)
#define MFMA16x32(a, b, c) __builtin_amdgcn_mfma_f32_16x16x32_bf16(a, b, c, 0, 0, 0)
constexpr int S2_CHB = 12544, S2_APT = 0, S2_RT = 2304, S2_WT = 4608, S2_BRT = 5120, S2_KRT = 5632, S2_B2T = 6144, S2_K2T = 8192, S2_VT = 10240, S2_GC = 12288;
constexpr int S2_PS = 2 * 4 * S2_CHB, S2_PSB = 8960, S2_AT = 0, S2_BT = 2304, S2_KT = 4608, S2_ATT = 6912;
constexpr int S2_N = 0, S2_NT = 512, S2_N2 = 1024, S2_N2T = 1536, S2_N4 = 2048, S2_N4T = 2560, S2_N8T = 3072, S2_P = 3584, S2_AAK = 4096, S2_TT = 4608;
constexpr int S2_CS = S2_PS + 4 * S2_PSB, S2_CSB = 2816, S2_SB = 0, S2_SG = 2304;
static_assert(S2_CS + 4 * S2_CSB <= LDS_BYTES, "scan LDS map");

__device__ __forceinline__ f32x4 mm64(const LAS unsigned char* A, const LAS unsigned char* B, f32x4 c, int l15, int g4) {
    const bf16x8 a0 = *(const LAS bf16x8*)(A + l15 * 144 + g4 * 16), a1 = *(const LAS bf16x8*)(A + l15 * 144 + g4 * 16 + 64);
    const bf16x8 b0 = *(const LAS bf16x8*)(B + l15 * 144 + g4 * 16), b1 = *(const LAS bf16x8*)(B + l15 * 144 + g4 * 16 + 64);
    c = MFMA16x32(a0, b0, c); c = MFMA16x32(a1, b1, c); return c; }
__device__ __forceinline__ f32x4 mm16(const LAS unsigned char* A, const LAS unsigned char* B, f32x4 c, int l15, int g4) {
    const s16x4 a = *(const LAS s16x4*)(A + l15 * 32 + g4 * 8), b = *(const LAS s16x4*)(B + l15 * 32 + g4 * 8);
    return MFMA16K16(a, b, c); }
__device__ __forceinline__ void st_T(LAS unsigned char* base, int row_bytes, f32x4 d, int l15, int g4) {
    u32x2 w; w.x = pk2(d[0], d[1]); w.y = pk2(d[2], d[3]); *(LAS u32x2*)(base + l15 * row_bytes + g4 * 8) = w; }
__device__ __forceinline__ void st_RM(LAS unsigned char* base, f32x4 d, int l15, int g4) {
#pragma unroll
    for (int i = 0; i < 4; ++i) *(LAS bf16_t*)(base + (4 * g4 + i) * 32 + l15 * 2) = f2bf(d[i]); }
__device__ __forceinline__ float wsum64(float x) {
    x = allred16(x);
    const float t0 = __int_as_float(__builtin_amdgcn_readlane(__float_as_int(x), 0)), t1 = __int_as_float(__builtin_amdgcn_readlane(__float_as_int(x), 16));
    const float t2 = __int_as_float(__builtin_amdgcn_readlane(__float_as_int(x), 32)), t3 = __int_as_float(__builtin_amdgcn_readlane(__float_as_int(x), 48));
    return (t0 + t1) + (t2 + t3); }

__device__ __forceinline__ void s2_load(const bf16_t* z, const bf16_t* lo, int b, int hc, int tok0, unsigned (&rw)[16][5], unsigned (&pv3)[3]) {
    const size_t row0 = (size_t)b * SEQ + tok0;
    pv3[0] = 0u; pv3[1] = 0u; pv3[2] = 0u;
    if (tok0 > 0) { const bf16_t* zp = z + (row0 - 1) * ZLD; pv3[0] = zp[ZR + hc]; pv3[1] = zp[ZK + hc]; pv3[2] = zp[ZV + hc]; }
#pragma unroll
    for (int t = 0; t < 16; ++t) {
        const bf16_t* zr = z + (row0 + t) * ZLD;
        rw[t][0] = zr[ZR + hc]; rw[t][1] = zr[ZK + hc]; rw[t][2] = zr[ZV + hc];
        rw[t][3] = lo[(row0 + t) * 1536 + hc]; rw[t][4] = lo[(row0 + t) * 1536 + 512 + hc];
    }
}
__device__ __forceinline__ void s2_produce(LAS unsigned char* CB, LAS unsigned char* PSb, LAS unsigned char* APTp, const unsigned (&rw)[16][5], const unsigned (&pv3)[3], int lane,
        float mur, float muk, float muv, float w0v, float a0v, float kkv, float kav) {
    const int l15 = lane & 15, g4 = lane >> 4;
    asm volatile("" ::: "memory");
    float pr = __uint_as_float(pv3[0] << 16), pk = __uint_as_float(pv3[1] << 16), pv = __uint_as_float(pv3[2] << 16);
    float btv[16], ktv[16]; unsigned atp[8], vtp[8];
    float Lam = 0.f, eP = 1.f, hold_a = 0.f, hold_v = 0.f;
#pragma unroll
    for (int t = 0; t < 16; ++t) {
        const float cr = __uint_as_float(rw[t][0] << 16), ck = __uint_as_float(rw[t][1] << 16), cv = __uint_as_float(rw[t][2] << 16);
        const float lw = __uint_as_float(rw[t][3] << 16), la = __uint_as_float(rw[t][4] << 16);
        const float r = cr + (pr - cr) * mur, k = ck + (pk - ck) * muk, v = cv + (pv - cv) * muv;
        pr = cr; pk = ck; pv = cv;
        const float aic = sigm(a0v + la);
        const float lam = -0.6065306597126334f * __builtin_amdgcn_rcpf(1.f + __expf(-(w0v + lw)));
        const float kk = k * kkv; const float ss = wsum64(kk * kk);
        const float kn = kk * rsqrtf(fmaxf(ss, 1e-24f));
        const float k2 = k * (1.f + (aic - 1.f) * kav);
        Lam += lam;
        const float eL = __expf(Lam), eLm = __builtin_amdgcn_rcpf(eL);
        const float at = -kn * eP, rt = r * eL, bt = kn * aic * eLm, kt = k2 * eLm;
        eP = eL;
        *(LAS bf16_t*)(PSb + S2_AT + t * 144 + lane * 2) = f2bf(at);
        *(LAS bf16_t*)(PSb + S2_BT + t * 144 + lane * 2) = f2bf(bt);
        *(LAS bf16_t*)(PSb + S2_KT + t * 144 + lane * 2) = f2bf(kt);
        *(LAS bf16_t*)(CB + S2_RT + t * 144 + lane * 2) = f2bf(rt);
        btv[t] = bt; ktv[t] = kt;
        if (t & 1) { atp[t >> 1] = pk2(hold_a, at); vtp[t >> 1] = pk2(hold_v, v); } else { hold_a = at; hold_v = v; }
    }
    const float gC = eP;
    *(LAS float*)(CB + S2_GC + lane * 4) = gC;
    { u32x4 w0 = {atp[0], atp[1], atp[2], atp[3]}, w1 = {atp[4], atp[5], atp[6], atp[7]};
      *(LAS u32x4*)(PSb + S2_ATT + lane * 32) = w0; *(LAS u32x4*)(PSb + S2_ATT + lane * 32 + 16) = w1;
      u32x4 v0 = {vtp[0], vtp[1], vtp[2], vtp[3]}, v1 = {vtp[4], vtp[5], vtp[6], vtp[7]};
      *(LAS u32x4*)(CB + S2_VT + lane * 32) = v0; *(LAS u32x4*)(CB + S2_VT + lane * 32 + 16) = v1;
      u32x4 b0, b1, k0, k1;
      b0.x = pk2(btv[0] * gC, btv[1] * gC); b0.y = pk2(btv[2] * gC, btv[3] * gC); b0.z = pk2(btv[4] * gC, btv[5] * gC); b0.w = pk2(btv[6] * gC, btv[7] * gC);
      b1.x = pk2(btv[8] * gC, btv[9] * gC); b1.y = pk2(btv[10] * gC, btv[11] * gC); b1.z = pk2(btv[12] * gC, btv[13] * gC); b1.w = pk2(btv[14] * gC, btv[15] * gC);
      k0.x = pk2(ktv[0] * gC, ktv[1] * gC); k0.y = pk2(ktv[2] * gC, ktv[3] * gC); k0.z = pk2(ktv[4] * gC, ktv[5] * gC); k0.w = pk2(ktv[6] * gC, ktv[7] * gC);
      k1.x = pk2(ktv[8] * gC, ktv[9] * gC); k1.y = pk2(ktv[10] * gC, ktv[11] * gC); k1.z = pk2(ktv[12] * gC, ktv[13] * gC); k1.w = pk2(ktv[14] * gC, ktv[15] * gC);
      *(LAS u32x4*)(CB + S2_B2T + lane * 32) = b0; *(LAS u32x4*)(CB + S2_B2T + lane * 32 + 16) = b1;
      *(LAS u32x4*)(CB + S2_K2T + lane * 32) = k0; *(LAS u32x4*)(CB + S2_K2T + lane * 32 + 16) = k1; }
    asm volatile("" ::: "memory");
    const f32x4 z4 = {0.f, 0.f, 0.f, 0.f};
    f32x4 dN = mm64(PSb + S2_BT, PSb + S2_AT, z4, l15, g4);
    f32x4 dAak = mm64(PSb + S2_KT, PSb + S2_AT, z4, l15, g4);
    f32x4 dBr = mm64(PSb + S2_BT, CB + S2_RT, z4, l15, g4);
    f32x4 dKr = mm64(PSb + S2_KT, CB + S2_RT, z4, l15, g4);
    f32x4 P;
#pragma unroll
    for (int i = 0; i < 4; ++i) { const int sidx = 4 * g4 + i;
        dN[i] = (sidx < l15) ? dN[i] : 0.f; dAak[i] = (sidx < l15) ? dAak[i] : 0.f;
        dBr[i] = (sidx <= l15) ? dBr[i] : 0.f; dKr[i] = (sidx <= l15) ? dKr[i] : 0.f;
        P[i] = dN[i] + ((sidx == l15) ? 1.f : 0.f); }
    asm volatile("s_waitcnt lgkmcnt(0)" ::: "memory");
    st_RM(PSb + S2_N, dN, l15, g4); st_T(PSb + S2_NT, 32, dN, l15, g4); st_RM(PSb + S2_AAK, dAak, l15, g4);
    st_T(CB + S2_BRT, 32, dBr, l15, g4); st_T(CB + S2_KRT, 32, dKr, l15, g4);
    st_RM(PSb + S2_P, P, l15, g4);
    asm volatile("" ::: "memory");
    const f32x4 n2 = mm16(PSb + S2_N, PSb + S2_NT, z4, l15, g4);
    asm volatile("" ::: "memory");
    st_RM(PSb + S2_N2, n2, l15, g4); st_T(PSb + S2_N2T, 32, n2, l15, g4);
    asm volatile("" ::: "memory");
    P = mm16(PSb + S2_P, PSb + S2_N2T, P, l15, g4);
    asm volatile("s_waitcnt lgkmcnt(0)" ::: "memory");
    st_RM(PSb + S2_P, P, l15, g4);
    asm volatile("" ::: "memory");
    const f32x4 n4 = mm16(PSb + S2_N2, PSb + S2_N2T, z4, l15, g4);
    asm volatile("" ::: "memory");
    st_RM(PSb + S2_N4, n4, l15, g4); st_T(PSb + S2_N4T, 32, n4, l15, g4);
    asm volatile("" ::: "memory");
    P = mm16(PSb + S2_P, PSb + S2_N4T, P, l15, g4);
    asm volatile("s_waitcnt lgkmcnt(0)" ::: "memory");
    st_RM(PSb + S2_P, P, l15, g4);
    asm volatile("" ::: "memory");
    const f32x4 n8 = mm16(PSb + S2_N4, PSb + S2_N4T, z4, l15, g4);
    asm volatile("" ::: "memory");
    st_T(PSb + S2_N8T, 32, n8, l15, g4);
    asm volatile("" ::: "memory");
    const f32x4 Tm = mm16(PSb + S2_P, PSb + S2_N8T, P, l15, g4);
    asm volatile("" ::: "memory");
    st_T(PSb + S2_TT, 32, Tm, l15, g4);
    asm volatile("" ::: "memory");
    const f32x4 W = mm16(PSb + S2_AAK, PSb + S2_TT, z4, l15, g4);
    asm volatile("" ::: "memory");
    st_T(CB + S2_WT, 32, W, l15, g4);
#pragma unroll
    for (int kt = 0; kt < 4; ++kt) {
        const f32x4 ap = mm16(PSb + S2_ATT + kt * 512, PSb + S2_TT, z4, l15, g4);
        st_T(APTp + kt * 32, 144, ap, l15, g4);
    }
}

__device__ __forceinline__ unsigned char* s2_block(unsigned char* ws, float* out, int c) {
    if (c < 10699) return ws + WS_RC + (size_t)c * S2_CHB;
    c -= 10699; if (c < 8024) return ws + WS_RA + (size_t)416 * MiB + (size_t)c * S2_CHB;
    c -= 8024; if (c < 5349) return (unsigned char*)out + (size_t)192 * MiB + (size_t)c * S2_CHB;
    c -= 5349; if (c < 2674) return ws + WS_LORAA + (size_t)c * S2_CHB;
    c -= 2674; return ws + WS_END + (size_t)c * S2_CHB;
}
__device__ __forceinline__ void scan_precompute(LAS unsigned char* lds, const Args& a, const bf16_t* z, const bf16_t* lo) {
    const int tid = threadIdx.x, lane = tid & 63, wid = __builtin_amdgcn_readfirstlane(tid >> 6);
    LAS unsigned char* WB = lds + wid * (S2_CHB - 2304 + S2_PSB);
    LAS unsigned char* CB = WB - 2304; LAS unsigned char* PSb = WB + (S2_CHB - 2304);
    const int nw = (int)gridDim.x * 8;
    unsigned rwA[16][5], pvA[3];
    { const int c = (int)blockIdx.x * 8 + wid; if (c < 32768) s2_load(z, lo, c >> 11, ((c >> 8) & 7) * 64 + lane, (c & 255) * 16, rwA, pvA); }
    const bool fixed_h = (nw & 2047) == 0;
    int hc = ((((int)blockIdx.x * 8 + wid) >> 8) & 7) * 64 + lane;
    float mur = a.in[16][hc], muk = a.in[16][512 + hc], muv = a.in[16][1024 + hc], w0v = a.in[17][hc], a0v = a.in[19][hc], kkv = a.in[22][hc], kav = a.in[23][hc];
    for (int c = (int)blockIdx.x * 8 + wid; c < 32768; c += nw) {
        if (!fixed_h) { hc = ((c >> 8) & 7) * 64 + lane;
            mur = a.in[16][hc]; muk = a.in[16][512 + hc]; muv = a.in[16][1024 + hc]; w0v = a.in[17][hc]; a0v = a.in[19][hc]; kkv = a.in[22][hc]; kav = a.in[23][hc]; }
        unsigned rwB[16][5], pvB[3];
        { const int cn = c + nw; if (cn < 32768) s2_load(z, lo, cn >> 11, ((cn >> 8) & 7) * 64 + lane, (cn & 255) * 16, rwB, pvB); }
        s2_produce(CB, PSb, PSb, rwA, pvA, lane, mur, muk, muv, w0v, a0v, kkv, kav);
#pragma unroll
        for (int t = 0; t < 16; ++t)
#pragma unroll
            for (int q = 0; q < 5; ++q) rwA[t][q] = rwB[t][q];
        pvA[0] = pvB[0]; pvA[1] = pvB[1]; pvA[2] = pvB[2];
        asm volatile("s_waitcnt lgkmcnt(0)" ::: "memory");
        u32x4* dst = (u32x4*)s2_block(a.ws, a.out, c);
#pragma unroll
        for (int k = 0; k < 3; ++k) { const int idx = lane + 64 * k; if (idx < 144) dst[idx] = *(const LAS u32x4*)(PSb + idx * 16); }
#pragma unroll
        for (int k = 0; k < 10; ++k) { const int idx = lane + 64 * k; dst[144 + idx] = *(const LAS u32x4*)(WB + idx * 16); }
        asm volatile("s_waitcnt lgkmcnt(0)" ::: "memory");
    }
}
__device__ __forceinline__ void scan_phase(LAS unsigned char* lds, const Args& a, const bf16_t* z, const bf16_t* lo, float* yraw) {
    const int tid = threadIdx.x, lane = tid & 63, wid = __builtin_amdgcn_readfirstlane(tid >> 6);
    const int l15 = lane & 15, g4 = lane >> 4;
    constexpr int NIT = SEQ / 64;
    for (int unit = blockIdx.x; unit < 128; unit += gridDim.x) {
        const int b = unit >> 3, h = unit & 7;
        __syncthreads();
        if (wid >= 4) {
            const int pw = wid - 4, c0 = unit * 256;
            { const u32x4* src = (const u32x4*)s2_block(a.ws, a.out, c0 + pw); LAS unsigned char* dstl = lds + (0 * 4 + pw) * S2_CHB;
              u32x4 tmp[13];
#pragma unroll
              for (int k = 0; k < 13; ++k) { const int idx = lane + 64 * k; if (idx < S2_CHB / 16) tmp[k] = src[idx]; }
#pragma unroll
              for (int k = 0; k < 13; ++k) { const int idx = lane + 64 * k; if (idx < S2_CHB / 16) *(LAS u32x4*)(dstl + idx * 16) = tmp[k]; } }
            __syncthreads();
            for (int it = 0; it < NIT; ++it) {
                if (it + 1 < NIT) { const u32x4* src = (const u32x4*)s2_block(a.ws, a.out, c0 + (it + 1) * 4 + pw); LAS unsigned char* dstl = lds + (((it + 1) & 1) * 4 + pw) * S2_CHB;
                  u32x4 tmp[13];
#pragma unroll
                  for (int k = 0; k < 13; ++k) { const int idx = lane + 64 * k; if (idx < S2_CHB / 16) tmp[k] = src[idx]; }
#pragma unroll
                  for (int k = 0; k < 13; ++k) { const int idx = lane + 64 * k; if (idx < S2_CHB / 16) *(LAS u32x4*)(dstl + idx * 16) = tmp[k]; } }
                __syncthreads();
            }
        } else {
            const int vt = wid;
            LAS unsigned char* SB = lds + S2_CS + vt * S2_CSB + S2_SB; LAS unsigned char* SG = lds + S2_CS + vt * S2_CSB + S2_SG;
            f32x4 St[4];
#pragma unroll
            for (int kt = 0; kt < 4; ++kt) St[kt] = (f32x4){0.f, 0.f, 0.f, 0.f};
            __syncthreads();
            for (int it = 0; it < NIT; ++it) {
                for (int j = 0; j < 4; ++j) {
                    const LAS unsigned char* CB = lds + ((it & 1) * 4 + j) * S2_CHB;
                    asm volatile("" ::: "memory");
                    s16x4 sbf[4];
#pragma unroll
                    for (int kt = 0; kt < 4; ++kt) { u32x2 w; w.x = pk2(St[kt][0], St[kt][1]); w.y = pk2(St[kt][2], St[kt][3]); sbf[kt] = __builtin_bit_cast(s16x4, w); }
                    const s16x4 vtf = *(const LAS s16x4*)(CB + S2_VT + (vt * 16 + l15) * 32 + g4 * 8);
                    f32x4 sg = {0.f, 0.f, 0.f, 0.f};
                    { const s16x4 wf = *(const LAS s16x4*)(CB + S2_WT + l15 * 32 + g4 * 8);
                      sg = MFMA16K16(wf, vtf, sg);
#pragma unroll
                      for (int kt = 0; kt < 4; ++kt) { const s16x4 af = *(const LAS s16x4*)(CB + S2_APT + l15 * 144 + kt * 32 + g4 * 8); sg = MFMA16K16(af, sbf[kt], sg); } }
                    s16x4 sgf; { u32x2 w; w.x = pk2(sg[0], sg[1]); w.y = pk2(sg[2], sg[3]); sgf = __builtin_bit_cast(s16x4, w); }
                    f32x4 yy = {0.f, 0.f, 0.f, 0.f};
                    { const s16x4 brf = *(const LAS s16x4*)(CB + S2_BRT + l15 * 32 + g4 * 8), krf = *(const LAS s16x4*)(CB + S2_KRT + l15 * 32 + g4 * 8);
                      yy = MFMA16K16(krf, vtf, yy);
#pragma unroll
                      for (int kt = 0; kt < 4; ++kt) { const s16x4 rf = *(const LAS s16x4*)(CB + S2_RT + l15 * 144 + kt * 32 + g4 * 8); yy = MFMA16K16(rf, sbf[kt], yy); }
                      yy = MFMA16K16(brf, sgf, yy); }
                    { bf16_t* yp = (bf16_t*)yraw + ((size_t)b * SEQ + it * 64 + j * 16 + 4 * g4) * 512 + h * 64 + vt * 16 + l15;
#pragma unroll
                      for (int i = 0; i < 4; ++i) yp[(size_t)i * 512] = f2bf(yy[i]); }
#pragma unroll
                    for (int kt = 0; kt < 4; ++kt) {
                        const f32x4 gc = *(const LAS f32x4*)(CB + S2_GC + (16 * kt + 4 * g4) * 4);
                        const s16x4 b2f = *(const LAS s16x4*)(CB + S2_B2T + (16 * kt + l15) * 32 + g4 * 8), k2f = *(const LAS s16x4*)(CB + S2_K2T + (16 * kt + l15) * 32 + g4 * 8);
                        f32x4 sn = St[kt] * gc;
                        sn = MFMA16K16(k2f, vtf, sn); sn = MFMA16K16(b2f, sgf, sn);
                        St[kt] = sn;
                    }
                }
                __syncthreads();
            }
        }
    }
}

constexpr int NS_KCL = 0, NS_VCL = 36864, NS_IMP = 70656, NS_SELM = 137216, NS_UNI = 137728;
constexpr int NS_KT = NS_IMP, NS_VT = NS_IMP + 9216;

#define MFMA16(a, b, c) __builtin_amdgcn_mfma_f32_16x16x32_bf16(a, b, c, 0, 0, 0)

template <int MODE>
__device__ __forceinline__ void flash_tile(const LAS unsigned char* lds, unsigned kt_off, unsigned vt_off, const bf16x8 (&Qf)[2][2], f32x4 (&O)[4][2],
        float (&mrun)[2], float (&lrun)[2], float slope, const int (&tq)[2], int key0, const bool (&selb)[2], int l15, int g4, bool full) {
    asm volatile("" : "+v"(kt_off), "+v"(vt_off));
    const LAS unsigned char* KT = lds + kt_off; const LAS unsigned char* VT = lds + vt_off;
    f32x4 sc[4][2];
    float cb[2];
#pragma unroll
    for (int qs = 0; qs < 2; ++qs) cb[qs] = slope * (float)(key0 + 4 * g4 - tq[qs]) + ((MODE == 1 && !selb[qs]) ? -1e30f : 0.f);
    __builtin_amdgcn_s_setprio(1);
#pragma unroll
    for (int s = 0; s < 4; ++s) {
        const LAS unsigned char* kp = KT + (s * 16) * 144;
        const bf16x8 k0 = *(const LAS bf16x8*)kp, k1 = *(const LAS bf16x8*)(kp + 64);
#pragma unroll
        for (int qs = 0; qs < 2; ++qs) {
            f32x4 zz;
#pragma unroll
            for (int i = 0; i < 4; ++i) zz[i] = fmaf(slope, (float)(s * 16 + i), cb[qs]);
            zz = MFMA16(k0, Qf[qs][0], zz);
            sc[s][qs] = MFMA16(k1, Qf[qs][1], zz);
        }
    }
    __builtin_amdgcn_s_setprio(0);
    if (!full) {
#pragma unroll
        for (int qs = 0; qs < 2; ++qs)
#pragma unroll
            for (int s = 0; s < 4; ++s)
#pragma unroll
                for (int i = 0; i < 4; ++i) {
                    const int dist = (tq[qs] - key0 - 4 * g4) - (s * 16 + i);
                    const bool ok = (MODE == 1) ? (dist >= 0) : (dist >= 0 && dist < 512);
                    sc[s][qs][i] = ok ? sc[s][qs][i] : -1e30f;
                }
    }
#pragma unroll
    for (int qs = 0; qs < 2; ++qs) {
        float mx = -1e30f;
#pragma unroll
        for (int s = 0; s < 4; ++s)
#pragma unroll
            for (int i = 0; i < 4; ++i) mx = fmaxf(mx, sc[s][qs][i]);
        mx = fmaxf(mx, __shfl_xor(mx, 16)); mx = fmaxf(mx, __shfl_xor(mx, 32));
        const float mn = fmaxf(mrun[qs], mx);
        const float alpha = __builtin_amdgcn_exp2f(mrun[qs] - mn);
        mrun[qs] = mn;
        const float mnx = fmaxf(mn, -1e29f);
        float ps = 0.f;
#pragma unroll
        for (int s = 0; s < 4; ++s)
#pragma unroll
            for (int i = 0; i < 4; ++i) { const float p = __builtin_amdgcn_exp2f(sc[s][qs][i] - mnx); sc[s][qs][i] = p; ps += p; }
        lrun[qs] = lrun[qs] * alpha + ps;
#pragma unroll
        for (int d = 0; d < 4; ++d) O[d][qs] = O[d][qs] * alpha;
    }
    __builtin_amdgcn_s_setprio(1);
#pragma unroll
    for (int kk = 0; kk < 2; ++kk) {
        bf16x8 Pf[2];
#pragma unroll
        for (int qs = 0; qs < 2; ++qs) { u32x4 w; w.x = pk2(sc[2 * kk][qs][0], sc[2 * kk][qs][1]); w.y = pk2(sc[2 * kk][qs][2], sc[2 * kk][qs][3]);
            w.z = pk2(sc[2 * kk + 1][qs][0], sc[2 * kk + 1][qs][1]); w.w = pk2(sc[2 * kk + 1][qs][2], sc[2 * kk + 1][qs][3]); Pf[qs] = __builtin_bit_cast(bf16x8, w); }
#pragma unroll
        for (int d = 0; d < 4; ++d) {
            const LAS unsigned char* vp = VT + (d * 16) * 144 + (kk * 32) * 2;
            const s16x4 lo = *(const LAS s16x4*)vp, hi = *(const LAS s16x4*)(vp + 32);
            const bf16x8 Vf = {lo[0], lo[1], lo[2], lo[3], hi[0], hi[1], hi[2], hi[3]};
#pragma unroll
            for (int qs = 0; qs < 2; ++qs) O[d][qs] = MFMA16(Vf, Pf[qs], O[d][qs]);
            }
    }
    __builtin_amdgcn_s_setprio(0);
}

__device__ __forceinline__ void nsa_fetch(u32x4& kv, u32x4& vv, const bf16_t* kbase, size_t kstride, const bf16_t* vtbase, size_t vstride, int tid) {
    const int row = tid >> 3, ch = tid & 7;
    kv = *(const u32x4*)(kbase + (size_t)row * kstride + ch * 8);
    vv = *(const u32x4*)(vtbase + (size_t)row * vstride + ch * 8);
}
__device__ __forceinline__ void nsa_commit(LAS unsigned char* lds, const u32x4 kv, const u32x4 vv, int tid) {
    const int row = tid >> 3, ch = tid & 7;
    *(LAS u32x4*)(lds + NS_KT + row * 144 + ch * 16) = kv;
    *(LAS u32x4*)(lds + NS_VT + row * 144 + ch * 16) = vv;
}

__device__ __forceinline__ void nsa_phase(LAS unsigned char* lds, const Args& a, const bf16_t* z, const bf16_t* KC, const bf16_t* VCT, const bf16_t* VST, const bf16_t* VWT, bf16_t* A2, int ldo, bool merged) {
    const int tid = threadIdx.x, lane = tid & 63, wid = __builtin_amdgcn_readfirstlane(tid >> 6);
    const int l15_ = lane & 15, g4_ = lane >> 4, hr = wid >> 1, qh = wid & 1;
    LAS float* IMP = (LAS float*)(lds + NS_IMP);
    LAS unsigned* SELM = (LAS unsigned*)(lds + NS_SELM);
    LAS unsigned* UNI = (LAS unsigned*)(lds + NS_UNI);
    const float* gbias = a.in[7];
#ifndef NSA_REP
#define NSA_REP 1
#endif
    const bool kc_resident = (gridDim.x & 31) == 0;
    if (kc_resident) {
        const int bg0 = (int)blockIdx.x & 31;
        __syncthreads();
#pragma unroll
        for (int it = 0; it < 4; ++it) {
            const int row = it * 64 + (tid >> 3), ch = tid & 7;
            *(LAS u32x4*)(lds + NS_KCL + row * 144 + ch * 16) = *(const u32x4*)(KC + ((size_t)bg0 * 256 + row) * 256 + ch * 8);
            const int dim = tid >> 3, c16 = (tid & 7) + 8 * it;
            *(LAS u32x4*)(lds + NS_VCL + dim * 528 + c16 * 16) = *(const u32x4*)(VCT + ((size_t)bg0 * 64 + dim) * 256 + c16 * 8);
        }
    }
    const int nun = merged ? (((int)blockIdx.x < 128) ? 7 : 9) : (2048 * NSA_REP - (int)blockIdx.x + (int)gridDim.x - 1) / (int)gridDim.x;
    for (int ui = 0; ui < nun; ++ui) {
        const int uu = merged ? ((ui < 8) ? (int)blockIdx.x + 256 * ui : (int)blockIdx.x - 128 + 1792) : (int)blockIdx.x + ui * (int)gridDim.x;
        const int unit = uu & 2047;
        const int bg = unit & 31, qt = ((unit >> 8) & 1) ? ((unit >> 5) ^ 7) : (unit >> 5), b = bg >> 1, g = bg & 1, t0 = qt * 64, cur = qt;
        const int hq = g * 4 + hr;
        const float slope = exp2f(-(float)(hq + 1)) * 1.4426950408889634f;
        const size_t row0 = (size_t)b * SEQ + t0;
        int l15 = l15_, g4 = g4_; asm volatile("" : "+v"(l15), "+v"(g4));
        int tidv = tid; asm volatile("" : "+v"(tidv));
        unsigned kt_off = NS_KT + l15 * 144 + g4 * 16, vt_off = NS_VT + l15 * 144 + g4 * 8;
        unsigned kcl_off = NS_KCL + l15 * 144 + g4 * 16, vcl_off = NS_VCL + l15 * 528 + g4 * 8;
        asm volatile("" : "+v"(kcl_off), "+v"(vcl_off));
        __syncthreads();
        if (!kc_resident) {
#pragma unroll
            for (int it = 0; it < 4; ++it) {
                const int row = it * 64 + (tid >> 3), ch = tid & 7;
                *(LAS u32x4*)(lds + NS_KCL + row * 144 + ch * 16) = *(const u32x4*)(KC + ((size_t)bg * 256 + row) * 256 + ch * 8);
                const int dim = tid >> 3, c16 = (tid & 7) + 8 * it;
                *(LAS u32x4*)(lds + NS_VCL + dim * 528 + c16 * 16) = *(const u32x4*)(VCT + ((size_t)bg * 64 + dim) * 256 + c16 * 8);
            }
        }
        if (tid == 0) { UNI[0] = 0u; UNI[1] = 0u; }
        bf16x8 Qf[2][2]; int tq[2]; float gate[2][3];
#pragma unroll
        for (int qs = 0; qs < 2; ++qs) {
            const int ql = qh * 32 + qs * 16 + l15; tq[qs] = t0 + ql;
            const bf16_t* zr = z + (row0 + ql) * ZLD;
            Qf[qs][0] = *(const bf16x8*)(zr + ZQ + hq * 64 + g4 * 8);
            Qf[qs][1] = *(const bf16x8*)(zr + ZQ + hq * 64 + 32 + g4 * 8);
#pragma unroll
            for (int br = 0; br < 3; ++br) gate[qs][br] = sigm(bf2f(zr[ZGT + hq * 3 + br]) + gbias[hq * 3 + br]);
        }
        f32x4 Y[4][2];
#pragma unroll
        for (int d = 0; d < 4; ++d) { Y[d][0] = (f32x4){0.f, 0.f, 0.f, 0.f}; Y[d][1] = Y[d][0]; }
        __syncthreads();
#ifndef NSA_NO_CMP
        const int tlmax = (4 * qt + 2) >> 6;
#pragma unroll
        for (int qs = 0; qs < 2; ++qs) {
            f32x4 sc[4][4];
            float mx = -1e30f;
#pragma unroll
            for (int tl = 0; tl < 4; ++tl) {
                if (tl <= tlmax) {
#pragma unroll
                    for (int s = 0; s < 4; ++s) {
                        const LAS unsigned char* kp = lds + kcl_off + (tl * 64 + s * 16) * 144;
                        const bf16x8 k0 = *(const LAS bf16x8*)kp, k1 = *(const LAS bf16x8*)(kp + 64);
                        const float cb = slope * (float)((tl * 1024 + s * 256 + 64 * g4 + 31) - tq[qs]);
                        f32x4 zz;
#pragma unroll
                        for (int i = 0; i < 4; ++i) zz[i] = fmaf(slope, 16.f * (float)i, cb);
                        zz = MFMA16(k0, Qf[qs][0], zz);
                        zz = MFMA16(k1, Qf[qs][1], zz);
                        if (!((64 * (tl + 1) - 1) <= (4 * qt - 2))) {
#pragma unroll
                            for (int i = 0; i < 4; ++i) {
                                const int dist = (tq[qs] - 31 - 64 * g4) - (tl * 1024 + s * 256 + 16 * i);
                                const bool ok = (dist >= 0) && !(tl == 3 && s == 3 && i == 3 && g4 == 3);
                                zz[i] = ok ? zz[i] : -1e30f;
                            }
                        }
#pragma unroll
                        for (int i = 0; i < 4; ++i) mx = fmaxf(mx, zz[i]);
                        sc[tl][s] = zz;
                        __builtin_amdgcn_sched_barrier(0);
                    }
                } else {
#pragma unroll
                    for (int s = 0; s < 4; ++s) sc[tl][s] = (f32x4){-1e30f, -1e30f, -1e30f, -1e30f};
                }
            }
            mx = fmaxf(mx, __shfl_xor(mx, 16)); mx = fmaxf(mx, __shfl_xor(mx, 32));
            const float mxx = fmaxf(mx, -1e29f);
            float ps = 0.f;
#pragma unroll
            for (int tl = 0; tl < 4; ++tl) {
                if (tl <= tlmax) {
#pragma unroll
                    for (int s = 0; s < 4; ++s)
#pragma unroll
                        for (int i = 0; i < 4; ++i) { const float p = __builtin_amdgcn_exp2f(sc[tl][s][i] - mxx); sc[tl][s][i] = p; ps += p; }
                } else {
#pragma unroll
                    for (int s = 0; s < 4; ++s) sc[tl][s] = (f32x4){0.f, 0.f, 0.f, 0.f};
                }
            }
            ps += __shfl_xor(ps, 16); ps += __shfl_xor(ps, 32);
            const float inv = ps > 0.f ? 1.f / ps : 0.f;
            unsigned imp_off = (unsigned)((hr * 64 + qh * 32 + qs * 16 + l15) * 65 + g4) * 4u; asm volatile("" : "+v"(imp_off));
            LAS float* impw = (LAS float*)(lds + NS_IMP + imp_off);
            float prev3 = 0.f;
#pragma unroll
            for (int tl = 0; tl < 4; ++tl) {
                if (tl <= tlmax) {
#pragma unroll
                    for (int s = 0; s < 4; ++s) {
                        f32x4 p = sc[tl][s] * inv; sc[tl][s] = p;
                        const float from_same = __shfl(p[3], (lane + 48) & 63);
                        const float from_prev = __shfl(prev3, (lane + 48) & 63);
                        const float p3m = (g4 > 0) ? from_same : from_prev;
                        impw[tl * 16 + s * 4] = p3m + 2.f * (p[0] + p[1] + p[2]) + p[3];
                        prev3 = p[3];
                    }
                } else {
#pragma unroll
                    for (int s = 0; s < 4; ++s) {
                        const float from_prev = __shfl(prev3, (lane + 48) & 63);
                        impw[tl * 16 + s * 4] = (g4 > 0) ? 0.f : from_prev;
                        prev3 = 0.f;
                    }
                }
            }
            f32x4 Oc[4];
#pragma unroll
            for (int d = 0; d < 4; ++d) Oc[d] = (f32x4){0.f, 0.f, 0.f, 0.f};
#pragma unroll
            for (int kk = 0; kk < 8; ++kk) {
                const int tl = kk >> 1, s0 = (kk & 1) * 2;
                if (tl <= tlmax) {
                    u32x4 w; w.x = pk2(sc[tl][s0][0], sc[tl][s0][1]); w.y = pk2(sc[tl][s0][2], sc[tl][s0][3]); w.z = pk2(sc[tl][s0 + 1][0], sc[tl][s0 + 1][1]); w.w = pk2(sc[tl][s0 + 1][2], sc[tl][s0 + 1][3]);
                    const bf16x8 Pf = __builtin_bit_cast(bf16x8, w);
#pragma unroll
                    for (int d = 0; d < 4; ++d) {
                        const LAS unsigned char* vp = lds + vcl_off + (d * 16) * 528 + (kk * 32) * 2;
                        const s16x4 lo = *(const LAS s16x4*)vp, hi = *(const LAS s16x4*)(vp + 32);
                        const bf16x8 Vf = {lo[0], lo[1], lo[2], lo[3], hi[0], hi[1], hi[2], hi[3]};
                        Oc[d] = MFMA16(Vf, Pf, Oc[d]);
                    }
                    __builtin_amdgcn_sched_barrier(0);
                }
            }
#pragma unroll
            for (int d = 0; d < 4; ++d) Y[d][qs] = Y[d][qs] + Oc[d] * gate[qs][0];
        }
#endif
        __syncthreads();
#ifndef NSA_NO_TOPK
        for (int qi = 0; qi < 8; ++qi) {
            const int q = wid * 8 + qi, j = lane;
            const float imp = ((IMP[(0 * 64 + q) * 65 + j] + IMP[(1 * 64 + q) * 65 + j]) + IMP[(2 * 64 + q) * 65 + j]) + IMP[(3 * 64 + q) * 65 + j];
            const bool forced = (j == 0) || (j == cur) || (j == cur - 1);
            const bool valid = (j <= cur);
            unsigned key = forced ? 0xFFFFFFC0u : (valid ? (__float_as_uint(fmaxf(imp, 0.f)) & 0xFFFFFFC0u) : 0u);
            key |= (unsigned)(63 - j);
            int rank = 0;
#pragma unroll 8
            for (int jp = 0; jp <= cur; ++jp) { const unsigned kj = (unsigned)__builtin_amdgcn_readlane((int)key, jp); rank += (kj > key) ? 1 : 0; }
            const unsigned long long mk = __ballot((rank < 16) && valid);
            if (lane == 0) { SELM[2 * q] = (unsigned)mk; SELM[2 * q + 1] = (unsigned)(mk >> 32); atomicOr((unsigned*)&UNI[0], (unsigned)mk); atomicOr((unsigned*)&UNI[1], (unsigned)(mk >> 32)); }
        }
#endif
        __syncthreads();
        const unsigned long long uni = ((unsigned long long)(unsigned)__builtin_amdgcn_readfirstlane((int)UNI[1]) << 32) | (unsigned)__builtin_amdgcn_readfirstlane((int)UNI[0]);
        unsigned long long msk[2];
#pragma unroll
        for (int qs = 0; qs < 2; ++qs) { const int ql = qh * 32 + qs * 16 + l15; msk[qs] = ((unsigned long long)SELM[2 * ql + 1] << 32) | SELM[2 * ql]; }
#ifndef NSA_NO_SEL
        {
            f32x4 O[4][2]; float mrun[2] = {-1e30f, -1e30f}, lrun[2] = {0.f, 0.f};
#pragma unroll
            for (int d = 0; d < 4; ++d) { O[d][0] = (f32x4){0.f, 0.f, 0.f, 0.f}; O[d][1] = O[d][0]; }
            unsigned long long rem = uni & ((cur >= 63) ? ~0ull : ((2ull << cur) - 1ull));
            u32x4 pkv = {0u, 0u, 0u, 0u}, pvv = pkv;
            int j = -1;
            if (rem) { j = __builtin_ctzll(rem); rem &= rem - 1ull;
                nsa_fetch(pkv, pvv, z + ((size_t)b * SEQ + j * 64) * ZLD + ZKS + g * 64, ZLD, VST + ((size_t)(b * 128 + g * 64)) * SEQ + j * 64, SEQ, tidv); }
            while (j >= 0) {
                __syncthreads();
                nsa_commit(lds, pkv, pvv, tidv);
                __syncthreads();
                const int jc = j;
                if (rem) { j = __builtin_ctzll(rem); rem &= rem - 1ull;
                    nsa_fetch(pkv, pvv, z + ((size_t)b * SEQ + j * 64) * ZLD + ZKS + g * 64, ZLD, VST + ((size_t)(b * 128 + g * 64)) * SEQ + j * 64, SEQ, tidv); }
                else j = -1;
                const bool selb[2] = {(bool)((msk[0] >> jc) & 1ull), (bool)((msk[1] >> jc) & 1ull)};
                flash_tile<1>(lds, kt_off, vt_off, Qf, O, mrun, lrun, slope, tq, jc * 64, selb, l15, g4, jc < cur);
            }
#pragma unroll
            for (int qs = 0; qs < 2; ++qs) {
                float l = lrun[qs]; l += __shfl_xor(l, 16); l += __shfl_xor(l, 32);
                const float sc1 = l > 0.f ? gate[qs][1] / l : 0.f;
#pragma unroll
                for (int d = 0; d < 4; ++d) Y[d][qs] = Y[d][qs] + O[d][qs] * sc1;
            }
        }
#endif
#ifndef NSA_NO_WIN
        {
            f32x4 O[4][2]; float mrun[2] = {-1e30f, -1e30f}, lrun[2] = {0.f, 0.f};
#pragma unroll
            for (int d = 0; d < 4; ++d) { O[d][0] = (f32x4){0.f, 0.f, 0.f, 0.f}; O[d][1] = O[d][0]; }
            const bool selb[2] = {true, true};
            u32x4 pkv, pvv;
            int j = (cur > 8 ? cur - 8 : 0);
            nsa_fetch(pkv, pvv, z + ((size_t)b * SEQ + j * 64) * ZLD + ZKW + g * 64, ZLD, VWT + ((size_t)(b * 128 + g * 64)) * SEQ + j * 64, SEQ, tidv);
            for (; j <= cur; ++j) {
                __syncthreads();
                nsa_commit(lds, pkv, pvv, tidv);
                __syncthreads();
                if (j < cur) nsa_fetch(pkv, pvv, z + ((size_t)b * SEQ + (j + 1) * 64) * ZLD + ZKW + g * 64, ZLD, VWT + ((size_t)(b * 128 + g * 64)) * SEQ + (j + 1) * 64, SEQ, tidv);
                flash_tile<2>(lds, kt_off, vt_off, Qf, O, mrun, lrun, slope, tq, j * 64, selb, l15, g4, (j < cur) && (j > cur - 8));
            }
#pragma unroll
            for (int qs = 0; qs < 2; ++qs) {
                float l = lrun[qs]; l += __shfl_xor(l, 16); l += __shfl_xor(l, 32);
                const float sc2 = l > 0.f ? gate[qs][2] / l : 0.f;
#pragma unroll
                for (int d = 0; d < 4; ++d) Y[d][qs] = Y[d][qs] + O[d][qs] * sc2;
            }
        }
#endif
#pragma unroll
        for (int qs = 0; qs < 2; ++qs) {
            bf16_t* op = A2 + (row0 + qh * 32 + qs * 16 + l15) * (size_t)ldo + hq * 64 + 4 * g4;
#pragma unroll
            for (int d = 0; d < 4; ++d) { u32x2 w; w.x = pk2(Y[d][qs][0], Y[d][qs][1]); w.y = pk2(Y[d][qs][2], Y[d][qs][3]); *(u32x2*)(op + d * 16) = w; }
        }
    }
}

__device__ __forceinline__ void rwkv_post(const Args& a, const bf16_t* z, const bf16_t* lo, const float* yraw, bf16_t* A2, const bf16_t* A2N) {
    const int tid = threadIdx.x, c8 = (tid & 7) * 8, h = (tid >> 3) & 7, tk = tid >> 6, hc = h * 64 + c8;
    float mur[8], muk[8], muv[8], a0v[8], kav[8], rkv[8], lw[8], lb[8];
#pragma unroll
    for (int i = 0; i < 8; ++i) { mur[i] = a.in[16][hc + i]; muk[i] = a.in[16][512 + hc + i]; muv[i] = a.in[16][1024 + hc + i];
        a0v[i] = a.in[19][hc + i]; kav[i] = a.in[23][hc + i]; rkv[i] = a.in[24][hc + i]; lw[i] = a.in[25][hc + i]; lb[i] = a.in[26][hc + i]; }
    u32x4 ncr, nck, ncv, npr, npk, npv, nla, nlg, nyw, nan_ = {0u, 0u, 0u, 0u};
#define PP_LOAD(it_) do { const size_t row_ = (size_t)(it_) * 8 + tk; const int t_ = (int)(row_ & (SEQ - 1)); const bf16_t* zr_ = z + row_ * ZLD; \
        ncr = *(const u32x4*)(zr_ + ZR + hc); nck = *(const u32x4*)(zr_ + ZK + hc); ncv = *(const u32x4*)(zr_ + ZV + hc); \
        npr = (u32x4){0u, 0u, 0u, 0u}; npk = npr; npv = npr; \
        if (t_ > 0) { const bf16_t* zp_ = zr_ - ZLD; npr = *(const u32x4*)(zp_ + ZR + hc); npk = *(const u32x4*)(zp_ + ZK + hc); npv = *(const u32x4*)(zp_ + ZV + hc); } \
        nla = *(const u32x4*)(lo + row_ * 1536 + 512 + hc); nlg = *(const u32x4*)(lo + row_ * 1536 + 1024 + hc); \
        nyw = *(const u32x4*)((const bf16_t*)yraw + row_ * 512 + hc); if (A2N) nan_ = *(const u32x4*)(A2N + row_ * 512 + hc); } while (0)
    if ((int)blockIdx.x < NTOK / 8) PP_LOAD(blockIdx.x);
    for (int it = blockIdx.x; it < NTOK / 8; it += gridDim.x) {
        const size_t row = (size_t)it * 8 + tk;
        const u32x4 cr = ncr, ck = nck, cv = ncv, pr = npr, pk = npk, pv = npv, la = nla, lg = nlg, yw = nyw, an = nan_;
        if (it + (int)gridDim.x < NTOK / 8) PP_LOAD(it + (int)gridDim.x);
        float fr_[8], fk[8], fv[8], gr[8], gk[8], gv[8], fla[8], fg[8];
        unpack8(cr, fr_); unpack8(ck, fk); unpack8(cv, fv); unpack8(pr, gr); unpack8(pk, gk); unpack8(pv, gv); unpack8(la, fla); unpack8(lg, fg);
        float y[8]; unpack8(yw, y);
        if (A2N) *(u32x4*)(A2 + row * DM + hc) = an;
        float bon = 0.f, sm = 0.f;
#pragma unroll
        for (int i = 0; i < 8; ++i) {
            fr_[i] = fr_[i] + (gr[i] - fr_[i]) * mur[i]; fk[i] = fk[i] + (gk[i] - fk[i]) * muk[i]; fv[i] = fv[i] + (gv[i] - fv[i]) * muv[i];
            const float av = sigm(a0v[i] + fla[i]);
            const float k2 = fk[i] * (1.f + (av - 1.f) * kav[i]);
            bon += fr_[i] * k2 * rkv[i]; sm += y[i];
        }
        bon += __shfl_xor(bon, 1); bon += __shfl_xor(bon, 2); bon += __shfl_xor(bon, 4);
        sm += __shfl_xor(sm, 1); sm += __shfl_xor(sm, 2); sm += __shfl_xor(sm, 4);
        const float mean = sm * (1.f / 64.f);
        float vs = 0.f;
#pragma unroll
        for (int i = 0; i < 8; ++i) { const float d = y[i] - mean; vs += d * d; }
        vs += __shfl_xor(vs, 1); vs += __shfl_xor(vs, 2); vs += __shfl_xor(vs, 4);
        const float rstd = rsqrtf(vs * (1.f / 64.f) + GN_EPS);
        float o[8];
#pragma unroll
        for (int i = 0; i < 8; ++i) o[i] = ((y[i] - mean) * rstd * lw[i] + lb[i] + bon * fv[i]) * fg[i];
        *(u32x4*)(A2 + row * DM + 512 + hc) = pack8(o);
    }
}

template <bool BASE_BF16>
__device__ __forceinline__ void row_pass(const void* base, const bf16_t* src, const float* psq, const float* gain, bf16_t* xb, float* rs_out, int gw, int NGW, int lane) {
    f32x4 gn[4];
#pragma unroll
    for (int j = 0; j < 4; ++j) gn[j] = *(const f32x4*)(gain + 4 * lane + 256 * j);
    f32x4 xa[4]; u32x2 sa[4]; float pa = 0.f;
#define RP_LOAD(m_, xv_, sv_, pq_) do { _Pragma("unroll") for (int j = 0; j < 4; ++j) { const size_t off = (size_t)(m_) * DM + 4 * lane + 256 * j; \
        if (BASE_BF16) { const u32x2 bw = *(const u32x2*)((const bf16_t*)base + off); xv_[j] = (f32x4){bf_lo(bw.x), bf_hi(bw.x), bf_lo(bw.y), bf_hi(bw.y)}; } \
        else xv_[j] = *(const f32x4*)((const float*)base + off); \
        sv_[j] = *(const u32x2*)(src + off); } \
        pq_ = (lane < 16) ? psq[(size_t)(m_) * 16 + lane] : 0.f; } while (0)
    if (gw < NTOK) RP_LOAD(gw, xa, sa, pa);
    for (int m = gw; m < NTOK; m += NGW) {
        f32x4 xn[4]; u32x2 sn[4]; float pn = 0.f;
        if (m + NGW < NTOK) RP_LOAD(m + NGW, xn, sn, pn);
        const float s = wave_sum(pa);
        const float rsm = rsqrtf(s * (1.f / DM) + NORM_EPS);
        float ss = 0.f;
#pragma unroll
        for (int j = 0; j < 4; ++j) {
            const size_t off = (size_t)m * DM + 4 * lane + 256 * j;
            const f32x4 sv = {bf_lo(sa[j].x), bf_hi(sa[j].x), bf_lo(sa[j].y), bf_hi(sa[j].y)};
            const f32x4 o = xa[j] + sv * rsm * gn[j];
            ss += o[0] * o[0] + o[1] * o[1] + o[2] * o[2] + o[3] * o[3];
            u32x2 w; w.x = pk2(o[0], o[1]); w.y = pk2(o[2], o[3]);
            *(u32x2*)(xb + off) = w;
        }
        if (rs_out) { ss = wave_sum(ss); if (lane == 0) rs_out[m] = rsqrtf(ss * (1.f / DM) + NORM_EPS); }
#pragma unroll
        for (int j = 0; j < 4; ++j) { xa[j] = xn[j]; sa[j] = sn[j]; }
        pa = pn;
    }
#undef RP_LOAD
}

#define XB_TMO      128
#define XB_XCNT(j)  (256  + 64 * (j))
#define XB_XSUB(j)  (1280 + 64 * (j))
#define XB_XGEN(j)  (2304 + 64 * (j))
#define XB_TOP      3328
#define XB_TOPGEN   3392
#define XCD_BAR_WORDS 3456
#define XB_SPIN_CAP (1u << 18)

__device__ __forceinline__ unsigned xb_ld(unsigned* p)              { return __hip_atomic_load(p, __ATOMIC_RELAXED, __HIP_MEMORY_SCOPE_AGENT); }
__device__ __forceinline__ unsigned xb_add(unsigned* p, unsigned v) { return __hip_atomic_fetch_add(p, v, __ATOMIC_RELAXED, __HIP_MEMORY_SCOPE_AGENT); }
__device__ __forceinline__ unsigned xb_xcc_id() { return (unsigned)__builtin_amdgcn_s_getreg((3 << 11) | 20) & 0xFu; }
#define XB_SPIN(cond, bar) do { unsigned _sp = 0; while (cond) { __builtin_amdgcn_s_sleep(1); \
    if ((++_sp & 255u) == 0u) { if (xb_ld(&(bar)[XB_TMO])) break; if (_sp > XB_SPIN_CAP) { atomicAdd(&(bar)[XB_TMO], 1u); break; } } } } while (0)

struct XcdBarrier {
    unsigned* bar; unsigned x;
    volatile LAS unsigned* st;
};

__device__ __forceinline__ XcdBarrier xcd_barrier_post(unsigned* bar, volatile LAS unsigned* st) {
    XcdBarrier b; b.bar = bar; b.x = xb_xcc_id(); b.st = st;
    if (threadIdx.x == 0) (void)xb_add(&bar[XB_XCNT(b.x)], 1u);
    return b;
}
__device__ __forceinline__ void xcd_barrier_complete(unsigned* bar, unsigned x, unsigned& nloc, unsigned& nx) {
    const unsigned G = gridDim.x * gridDim.y * gridDim.z;
    unsigned sum, cnt, mine, sp = 0u;
    for (;;) {
        sum = 0u; cnt = 0u; mine = 0u;
#pragma unroll
        for (unsigned j = 0; j < 16; ++j) { const unsigned c = xb_ld(&bar[XB_XCNT(j)]); sum += c; cnt += (c > 0u) ? 1u : 0u; mine = (j == x) ? c : mine; }
        if (sum == G) break;
        __builtin_amdgcn_s_sleep(1);
        if ((++sp & 255u) == 0u) { if (xb_ld(&bar[XB_TMO])) break; if (sp > XB_SPIN_CAP) { atomicAdd(&bar[XB_TMO], 1u); break; } }
    }
    nloc = mine > 0u ? mine : 1u; nx = cnt > 0u ? cnt : 1u;
}

__device__ __forceinline__ void xcd_barrier(const XcdBarrier& b) {
    asm volatile("s_waitcnt vmcnt(0)" ::: "memory");
    __syncthreads();
    if (threadIdx.x == 0) {
        unsigned* bar = b.bar;
        __builtin_amdgcn_s_waitcnt(0);
        unsigned nloc = b.st[0], nx = b.st[1];
        if (nloc == 0u) { xcd_barrier_complete(bar, b.x, nloc, nx); b.st[0] = nloc; b.st[1] = nx; }
        const unsigned old = xb_add(&bar[XB_XSUB(b.x)], 1u);
        const unsigned gen = old / nloc;
        if (old + 1u == (gen + 1u) * nloc) {
            __builtin_amdgcn_fence(__ATOMIC_RELEASE, "agent");
            asm volatile("s_waitcnt vmcnt(0)" ::: "memory");
            const unsigned og = xb_add(&bar[XB_TOP], 1u);
            const unsigned tg = og / nx;
            if (og + 1u == (tg + 1u) * nx) xb_add(&bar[XB_TOPGEN], 1u);
            else XB_SPIN(xb_ld(&bar[XB_TOPGEN]) == tg, bar);
            __builtin_amdgcn_fence(__ATOMIC_ACQUIRE, "agent");
            xb_add(&bar[XB_XGEN(b.x)], 1u);
            asm volatile("s_waitcnt vmcnt(0)" ::: "memory");
        } else {
            XB_SPIN(xb_ld(&bar[XB_XGEN(b.x)]) == gen, bar);
            __builtin_amdgcn_fence(__ATOMIC_ACQUIRE, "agent");
            asm volatile("s_waitcnt vmcnt(0)" ::: "memory");
        }
    }
    __syncthreads();
}

__global__ void __launch_bounds__(512, 2) hymba_fwd(Args a) {
    extern __shared__ __attribute__((aligned(16))) unsigned char lds_raw[];
    LAS unsigned char* lds = (LAS unsigned char*)lds_raw;
    cg::grid_group grid = cg::this_grid();
    const int tid = threadIdx.x, lane = tid & 63, wid = __builtin_amdgcn_readfirstlane(tid >> 6);
    const int G = gridDim.x, bx = blockIdx.x, gw = bx * 8 + wid, NGW = G * 8;
    unsigned char* ws = a.ws;
    bf16_t* WIN_T = (bf16_t*)(ws + WS_WIN); bf16_t* WOUT_T = (bf16_t*)(ws + WS_WOUT); bf16_t* WUP_T = (bf16_t*)(ws + WS_WUP); bf16_t* WDN_T = (bf16_t*)(ws + WS_WDN);
    bf16_t* WPLE_T = (bf16_t*)(ws + WS_WPLE); bf16_t* WPG_T = (bf16_t*)(ws + WS_WPG);
    bf16_t* CK1_T = (bf16_t*)(ws + WS_CK1); bf16_t* CV1_T = (bf16_t*)(ws + WS_CV1); bf16_t* CK2_T = (bf16_t*)(ws + WS_CK2); bf16_t* CV2_T = (bf16_t*)(ws + WS_CV2); bf16_t* LORA_T = (bf16_t*)(ws + WS_LORAT);
    float* BIAS1 = (float*)(ws + WS_BIAS1); float* RS1 = (float*)(ws + WS_RS1); float* RS2 = (float*)(ws + WS_RS2); float* PSQ = (float*)(ws + WS_PSQ);
    bf16_t* CHK = (bf16_t*)(ws + WS_CHK); bf16_t* CHV = (bf16_t*)(ws + WS_CHV); bf16_t* KC = (bf16_t*)(ws + WS_KC); bf16_t* VCT = (bf16_t*)(ws + WS_VCT);
    bf16_t* VST = (bf16_t*)(ws + WS_VST); bf16_t* VWT = (bf16_t*)(ws + WS_VWT);
    bf16_t* PB = (bf16_t*)(ws + WS_PB); bf16_t* LORA_A = (bf16_t*)(ws + WS_LORAA);
    bf16_t* RB = (bf16_t*)(ws + WS_RB); bf16_t* RC = (bf16_t*)(ws + WS_RC); bf16_t* RA = (bf16_t*)(ws + WS_RA);
    bf16_t* Z = RA; bf16_t* LORA_O = (bf16_t*)a.out;
    const int lo = a.ph_lo, hi = a.ph_hi;
#ifndef PHMASK
#define PHMASK 0xFFF
#endif
#define IN(k) (((PHMASK >> (k)) & 1) && lo <= (k) && (k) < hi)
    volatile LAS unsigned* xst = (volatile LAS unsigned*)(lds + LDS_BYTES - 16);
    if (tid == 0) { xst[0] = 0u; xst[1] = 0u; }
    __syncthreads();
    if (bx == 0) for (int i = tid; i < 4096; i += 512) ((unsigned*)ws)[i] = 0u;
    grid.sync();
    const XcdBarrier xbar = xcd_barrier_post((unsigned*)ws, xst);
#define SEAM(k) do { if (IN(k) && IN((k) + 1)) xcd_barrier(xbar); } while (0)
    const Epi<0> proto0{nullptr, 0, nullptr, nullptr, nullptr, nullptr, nullptr, nullptr};
    (void)proto0;

    if (IN(0)) {
        LAS float* scr = (LAS float*)(lds + wid * 16384);
        const float* w_in = a.in[6];
        tr_matrix(w_in, 1024, 3096, 0, 512, WIN_T, 1024, 0, 0, a.in[2], 0.125f * 1.4426950408889634f, scr, gw, NGW, lane);
        tr_matrix(w_in, 1024, 3096, 512, 384, WIN_T, 1024, 512, 0, a.in[2], 1.f, scr, gw, NGW, lane);
        tr_matrix(w_in, 1024, 3096, 896, 128, WIN_T, 1024, ZVS, 0, a.in[2], 1.f, scr, gw, NGW, lane);
        tr_matrix(w_in, 1024, 3096, 1024, 128, WIN_T, 1024, ZKW, 0, a.in[2], 1.f, scr, gw, NGW, lane);
        tr_matrix(w_in, 1024, 3096, 1152, 128, WIN_T, 1024, ZVW, 0, a.in[2], 1.f, scr, gw, NGW, lane);
        tr_matrix(w_in, 1024, 3096, 1280, 24, WIN_T, 1024, ZGT, 0, a.in[2], 1.f, scr, gw, NGW, lane);
        tr_matrix(w_in, 1024, 3096, 1304, 1792, WIN_T, 1024, ZR, 0, a.in[2], 1.f, scr, gw, NGW, lane);
        tr_matrix(a.in[27], 1024, 1024, 0, 1024, WOUT_T, 1024, 0, 0, nullptr, 1.f, scr, gw, NGW, lane);
        tr_matrix(a.in[28], 1024, 4096, 0, 4096, WUP_T, 1024, 0, 0, a.in[4], 1.f, scr, gw, NGW, lane);
        tr_matrix(a.in[29], 4096, 1024, 0, 1024, WDN_T, 4096, 0, 0, nullptr, 1.f, scr, gw, NGW, lane);
        tr_matrix(a.in[30], 256, 1024, 0, 1024, WPLE_T, 256, 0, 0, nullptr, 1.f, scr, gw, NGW, lane);
        tr_matrix(a.in[31], 1024, 1024, 0, 1024, WPG_T, 1024, 0, 0, nullptr, 1.f, scr, gw, NGW, lane);
        tr_matrix(a.in[9], 2048, 128, 0, 128, CK1_T, 2048, 0, 0, nullptr, 1.f, scr, gw, NGW, lane);
        tr_matrix(a.in[13], 2048, 128, 0, 128, CV1_T, 2048, 0, 0, nullptr, 1.f, scr, gw, NGW, lane);
        tr_matrix(a.in[11], 128, 64, 0, 64, CK2_T, 256, 0, 0, nullptr, 1.f, scr, gw, NGW, lane);
        tr_matrix(a.in[15], 128, 64, 0, 64, CV2_T, 256, 0, 0, nullptr, 1.f, scr, gw, NGW, lane);
        tr_matrix(a.in[18], 64, 512, 0, 512, LORA_T, 256, 0, 0, nullptr, 1.f, scr, gw, NGW, lane);
        tr_matrix(a.in[20], 64, 512, 0, 512, LORA_T, 256, 512, 64, nullptr, 1.f, scr, gw, NGW, lane);
        tr_matrix(a.in[21], 128, 512, 0, 512, LORA_T, 256, 1024, 128, nullptr, 1.f, scr, gw, NGW, lane);
        for (int i = bx * 512 + tid; i < 1536 * 32 + 2 * 64 * 16; i += G * 512) {
            if (i < 1536 * 32) { const int row = i >> 5, c8 = i & 31; const int lo8 = row < 512 ? 0 : (row < 1024 ? 8 : 16), hi8 = row < 512 ? 8 : (row < 1024 ? 16 : 32);
                if (c8 < lo8 || c8 >= hi8) *(u32x4*)(LORA_T + (size_t)row * 256 + c8 * 8) = (u32x4){0u, 0u, 0u, 0u}; }
            else { const int k = i - 1536 * 32, which = k >> 10, row = (k >> 4) & 63, c8 = 16 + (k & 15);
                *(u32x4*)((which ? CV2_T : CK2_T) + (size_t)row * 256 + c8 * 8) = (u32x4){0u, 0u, 0u, 0u}; }
        }
        if (gw < 256) {
            const int which = gw >> 7, n = gw & 127;
            const float* pe = which ? a.in[12] : a.in[8]; const float* w1 = which ? a.in[13] : a.in[9]; const float* b1 = which ? a.in[14] : a.in[10];
            float s = 0.f;
            for (int k = lane; k < 2048; k += 64) s += pe[k] * w1[(size_t)k * 128 + n];
            s = wave_sum(s);
            if (lane == 0) { BIAS1[which * 256 + n] = s + b1[n]; BIAS1[which * 256 + 128 + n] = 0.f; }
        }
        bf16_t* XB = RB;
        f32x4 vn[4];
        if (gw < NTOK) { const f32x4* xr0 = (const f32x4*)(a.in[0] + (size_t)gw * DM) + lane;
#pragma unroll
            for (int j = 0; j < 4; ++j) vn[j] = xr0[64 * j]; }
        for (int m = gw; m < NTOK; m += NGW) {
            f32x4 v[4]; float s = 0.f;
#pragma unroll
            for (int j = 0; j < 4; ++j) v[j] = vn[j];
            if (m + NGW < NTOK) { const f32x4* xr1 = (const f32x4*)(a.in[0] + (size_t)(m + NGW) * DM) + lane;
#pragma unroll
                for (int j = 0; j < 4; ++j) vn[j] = xr1[64 * j]; }
#pragma unroll
            for (int j = 0; j < 4; ++j) s += (v[j][0] * v[j][0] + v[j][1] * v[j][1]) + (v[j][2] * v[j][2] + v[j][3] * v[j][3]);
            s = wave_sum(s);
            if (lane == 0) RS1[m] = rsqrtf(s * (1.f / DM) + NORM_EPS);
            u32x2* o8 = (u32x2*)(XB + (size_t)m * DM) + lane;
#pragma unroll
            for (int j = 0; j < 4; ++j) { u32x2 w; w.x = pk2(v[j][0], v[j][1]); w.y = pk2(v[j][2], v[j][3]); o8[64 * j] = w; }
        }
        for (size_t i = (size_t)bx * 512 + tid; i < (size_t)NTOK * 256 / 8; i += (size_t)G * 512) {
            const f32x4 p0 = *(const f32x4*)(a.in[1] + i * 8), p1 = *(const f32x4*)(a.in[1] + i * 8 + 4);
            u32x4 w; w.x = pk2(p0[0], p0[1]); w.y = pk2(p0[2], p0[3]); w.z = pk2(p1[0], p1[1]); w.w = pk2(p1[2], p1[3]);
            *(u32x4*)(PB + i * 8) = w;
        }
    }
    SEAM(0);
    if (IN(1)) {
        Epi<0> E{Z, ZLD, RS1, nullptr, nullptr, VST, nullptr, nullptr};
        run_gemm<0>(lds, RB, WIN_T, NTOK, ZLD, 1024, 1024, 128, 0, bx, E);
    }
    SEAM(1);
    if (IN(2)) {
        { Epi<1> E{CHK, 256, nullptr, BIAS1, nullptr, nullptr, nullptr, nullptr};
          run_gemm<1>(lds, Z + ZKC, CK1_T, 8192, 256, 2048, 16 * ZLD, (long)ZLD * 2, 1, bx, E); }
        { Epi<1> E{CHV, 256, nullptr, BIAS1 + 256, nullptr, nullptr, nullptr, nullptr};
          run_gemm<1>(lds, Z + ZVC, CV1_T, 8192, 256, 2048, 16 * ZLD, (long)ZLD * 2, 1, (bx + G / 2) % G, E); }
        const float* mu = a.in[16] + 1536;
        const bool has_cmp = (G == 256) && (bx < 32 || (bx >= 128 && bx < 160));
        const int eb = (G == 256) ? (bx < 128 ? bx - 32 : bx - 64) : bx, eG = (G == 256) ? 192 : G;
        if (!has_cmp)
        for (size_t i = (size_t)eb * 512 + tid; i < (size_t)NTOK * 32; i += (size_t)eG * 512) {
            const size_t row = i >> 5; const int col = (int)(i & 31) * 8; const int t = (int)(row & (SEQ - 1));
            const bf16_t* zr = Z + row * ZLD + ZWD + col;
            const u32x4 cw = *(const u32x4*)zr; u32x4 pw = {0u, 0u, 0u, 0u};
            if (t > 0) pw = *(const u32x4*)(zr - ZLD);
            float c[8], p[8]; unpack8(cw, c); unpack8(pw, p);
#pragma unroll
            for (int j = 0; j < 8; ++j) {
                float v = c[j] + (p[j] - c[j]) * mu[col + j];
                if (col < 64) { const float e = __expf(2.f * v); v = 1.f - 2.f / (e + 1.f); }
                else if (col >= 128) v = sigm(v);
                c[j] = v;
            }
            *(u32x4*)(LORA_A + row * 256 + col) = pack8(c);
        }
    }
    SEAM(2);
    if (IN(3)) {
#ifndef P3_SKIP1
        { Epi<2> E{LORA_O, 1536, nullptr, nullptr, nullptr, nullptr, nullptr, nullptr};
          run_gemm<2>(lds, LORA_A, LORA_T, NTOK, 1536, 256, 256, 128, 0, bx, E); }
#endif
#ifndef P3_SKIP2
        { Epi<2> E{KC, 256, nullptr, nullptr, nullptr, nullptr, nullptr, nullptr};
          run_gemm<2>(lds, CHK, CK2_T, 8192, 256, 256, 256, 128, 0, bx, E); }
#endif
#ifndef P3_SKIP3
        { Epi<3> E{nullptr, 0, nullptr, nullptr, nullptr, VCT, nullptr, nullptr};
          run_gemm<3>(lds, CHV, CV2_T, 8192, 256, 256, 256, 128, 0, (bx + G / 2) % G, E); }
#endif
    }
    SEAM(3);
#ifndef REP4
#define REP4 1
#endif
#ifndef REP5
#define REP5 1
#endif
    const bool merged45 = (G == 256) && IN(4) && IN(5);
    bf16_t* A2N = RB + (size_t)NTOK * 512;
    if (IN(4)) { scan_precompute(lds, a, Z, LORA_O); xcd_barrier(xbar); scan_phase(lds, a, Z, LORA_O, (float*)RB);
                 if (merged45) nsa_phase(lds, a, Z, KC, VCT, VST, VWT, A2N, 512, true); }
    SEAM(4);
    if (IN(5)) for (int rep = 0; rep < REP5; ++rep) {
#ifndef NO_NSA
        if (!merged45) nsa_phase(lds, a, Z, KC, VCT, VST, VWT, RC, DM, false);
#endif
#ifndef NO_POST
        rwkv_post(a, Z, LORA_O, (const float*)RB, RC, merged45 ? A2N : (const bf16_t*)nullptr);
#endif
    }
    SEAM(5);
    if (IN(6)) {
        Epi<4> E{RB, DM, nullptr, nullptr, PSQ, nullptr, nullptr, nullptr};
        run_gemm<4>(lds, RC, WOUT_T, NTOK, DM, DM, DM, 128, 0, bx, E);
    }
    SEAM(6);
    if (IN(7)) row_pass<false>(a.in[0], RB, PSQ, a.in[3], RC, RS2, gw, NGW, lane);
    SEAM(7);
    if (IN(8)) {
        Epi<5> E{RA, DFF, RS2, nullptr, nullptr, nullptr, nullptr, nullptr};
        run_gemm<5>(lds, RC, WUP_T, NTOK, DFF, DM, DM, 128, 0, bx, E);
    }
    SEAM(8);
    if (IN(9)) {
        Epi<4> E{RB, DM, nullptr, nullptr, PSQ, nullptr, nullptr, nullptr};
        run_gemm<4>(lds, RA, WDN_T, NTOK, DM, DFF, DFF, 128, 0, bx, E);
    }
    SEAM(9);
    if (IN(10)) {
        { Epi<2> E{RA, DM, nullptr, nullptr, nullptr, nullptr, nullptr, nullptr};
          run_gemm<2>(lds, PB, WPLE_T, NTOK, DM, 256, 256, 128, 0, bx, E); }
        row_pass<true>(RC, RB, PSQ, a.in[5], RC, nullptr, gw, NGW, lane);
    }
    SEAM(10);
    if (IN(11)) {
        Epi<6> E{RC, DM, nullptr, nullptr, nullptr, nullptr, a.out, RA};
        run_gemm<6>(lds, RC, WPG_T, NTOK, DM, DM, DM, 128, 0, bx, E);
    }
#undef IN
#undef SEAM
}

extern "C" void kernel_launch(void* const* d_in, const int* in_sizes, int n_in, void* d_out, int out_size, void* d_ws, size_t ws_size, hipStream_t stream) {
    static int grid = 0;
    if (grid == 0) {
        if (n_in != 32 || out_size != NTOK * DM || ws_size < (size_t)992 * MiB) { fprintf(stderr, "kernel_launch: unexpected shapes (n_in %d out %d ws %zu)\n", n_in, out_size, ws_size); grid = -1; return; }
        int dev = 0, cus = 0, per_cu = 0;
        hipGetDevice(&dev);
        hipDeviceGetAttribute(&cus, hipDeviceAttributeMultiprocessorCount, dev);
        if (hipFuncSetAttribute((const void*)hymba_fwd, hipFuncAttributeMaxDynamicSharedMemorySize, LDS_BYTES) != hipSuccess) { fprintf(stderr, "kernel_launch: hipFuncSetAttribute failed\n"); grid = -1; return; }
        hipOccupancyMaxActiveBlocksPerMultiprocessor(&per_cu, (const void*)hymba_fwd, 512, LDS_BYTES);
        (void)hipGetLastError();
        if (per_cu < 1) fprintf(stderr, "kernel_launch: occupancy query reports %d blocks per CU\n", per_cu);
        grid = cus;
    }
    if (grid < 0) return;
    Args a{};
    for (int i = 0; i < 32; ++i) a.in[i] = (const float*)d_in[i];
    a.out = (float*)d_out; a.ws = (unsigned char*)d_ws;
#if N_LAUNCH_MODE == 1
    a.ph_lo = 0; a.ph_hi = NPHASE;
    { void* args[] = {&a};
      hipError_t e = hipLaunchCooperativeKernel((const void*)hymba_fwd, dim3(grid), dim3(512), args, LDS_BYTES, stream);
      if (e != hipSuccess) fprintf(stderr, "cooperative launch failed: %s (grid %d)\n", hipGetErrorString(e), grid); }
#else
    for (int ph = 0; ph < NPHASE; ++ph) {
        a.ph_lo = ph; a.ph_hi = ph + 1;
        void* args[] = {&a};
        hipError_t e = hipLaunchCooperativeKernel((const void*)hymba_fwd, dim3(grid), dim3(512), args, LDS_BYTES, stream);
        if (e != hipSuccess) { fprintf(stderr, "launch %d failed: %s (grid %d)\n", ph, hipGetErrorString(e), grid); break; }
    }
#endif
}
```
